# Optimizing an MI355X kernel written in HIP

```python
import math
import jax
import jax.numpy as jnp
from jax import lax
import numpy as np

D_MODEL = 1024
BATCH = 4
SEQ = 4096
DEPTH = 2

CTX_LEN = 256
GRID_W = 64

D_FF = 2816
MACARON_WEIGHT = 0.5
N_MOD = 9
EPS = 1e-6

GLA_HEADS = 4
GLA_DK = 128
GLA_DV = 256
GLA_LOWRANK = 16
GLA_TAU = 16.0
GLA_CHUNK = 64

HY_WIDTH = 1024
HY_ORDER = 2
HY_SHORT = 3
HY_EMB = 33
HY_HIDDEN = 64
HY_FAST_DECAY = 0.3
HY_SLOW_DECAY = 1.5
HY_DECAY_TARGET = 1e-2

KEY_W = GLA_HEADS * GLA_DK
VAL_W = GLA_HEADS * GLA_DV
ALPHA_W = 2 * GLA_LOWRANK
OFF_K = 0
OFF_V = OFF_K + KEY_W
OFF_A = OFF_V + VAL_W
OFF_Q = OFF_A + ALPHA_W
OFF_R = OFF_Q + KEY_W
OFF_H = OFF_R + VAL_W
OFF_G = OFF_H + (HY_ORDER + 1) * HY_WIDTH
IN_W = OFF_G + 2 * D_MODEL

kernel_name = 'hybrid_gla_hyena_prefix_dit'


def rms_norm(x, g):
    xf = x.astype(jnp.float32)
    y = xf * lax.rsqrt(jnp.mean(xf * xf, axis=-1, keepdims=True) + EPS)
    return (y * g.astype(jnp.float32)).astype(x.dtype)


def modulate(h, shift, scale):
    return h * (1.0 + scale) + shift


def swiglu(h, w_gate, w_up, w_down):
    return (jax.nn.silu(h @ w_gate) * (h @ w_up)) @ w_down


def ffn_sublayer(x, mod, norm_g, w_gate, w_up, w_down):
    shift, scale, gate = mod
    y = swiglu(modulate(rms_norm(x, norm_g), shift, scale), w_gate, w_up, w_down)
    return x + MACARON_WEIGHT * gate * y


def gla_zero_state(batch):
    return jnp.zeros((batch, GLA_HEADS, GLA_DK, GLA_DV), jnp.float32)


def gla_inputs(p, wa_f, ba_f, wa_b, ba_b):
    bsz, L, _ = p.shape
    k = p[..., OFF_K:OFF_V].reshape(bsz, L, GLA_HEADS, GLA_DK)
    v = p[..., OFF_V:OFF_A].reshape(bsz, L, GLA_HEADS, GLA_DV)
    a = p[..., OFF_A:OFF_Q].astype(jnp.float32)
    la_f = jax.nn.log_sigmoid(a[..., :GLA_LOWRANK] @ wa_f.astype(jnp.float32) + ba_f.astype(jnp.float32)) / GLA_TAU
    la_b = jax.nn.log_sigmoid(a[..., GLA_LOWRANK:] @ wa_b.astype(jnp.float32) + ba_b.astype(jnp.float32)) / GLA_TAU
    shape = (bsz, L, GLA_HEADS, GLA_DK)
    return k, v, la_f.reshape(shape), la_b.reshape(shape)


def gla_query(p):
    bsz, L, _ = p.shape
    return p[..., OFF_Q:OFF_R].reshape(bsz, L, GLA_HEADS, GLA_DK)


def gla_chunk_states(k, v, log_a, s0):
    bsz, L, H, DK = k.shape
    n = L // GLA_CHUNK
    resh = lambda t: t.reshape(bsz, n, GLA_CHUNK, H, t.shape[-1]).astype(jnp.float32)
    kc, vc, la = resh(k), resh(v), resh(log_a)
    b = jnp.cumsum(la, axis=2)
    b_last = b[:, :, -1]
    k_end = kc * jnp.exp(b_last[:, :, None] - b)
    du = jnp.einsum('bnchk,bnchv->nbhkv', k_end, vc)
    decay = jnp.moveaxis(jnp.exp(b_last), 1, 0)

    def step(s, inp):
        d, u = inp
        return d[..., None] * s + u, s

    s_fin, s_start = lax.scan(step, s0.astype(jnp.float32), (decay, du))
    return b, kc, vc, s_start, s_fin


def gla_scan(q, k, v, log_a, s0):
    bsz, L, H, DK = q.shape
    b, kc, vc, s_start, s_fin = gla_chunk_states(k, v, log_a, s0)
    qc = q.reshape(bsz, L // GLA_CHUNK, GLA_CHUNK, H, DK).astype(jnp.float32) * (DK ** -0.5)
    q_dec = qc * jnp.exp(b)
    o_inter = jnp.einsum('bnchk,nbhkv->bnchv', q_dec, s_start)
    att = jnp.einsum('bnihk,bnjhk->bnhij', q_dec, kc * jnp.exp(-b))
    lower = jnp.tril(jnp.ones((GLA_CHUNK, GLA_CHUNK), dtype=bool))
    att = jnp.where(lower, att, 0.0)
    o_intra = jnp.einsum('bnhij,bnjhv->bnihv', att, vc)
    o = (o_inter + o_intra).reshape(bsz, L, H, v.shape[-1]).astype(v.dtype)
    return o, s_fin


def flip_seq(t):
    return jnp.flip(t, axis=1)


def gla_bidir(q, k, v, la_f, la_b, s_f0, s_b0):
    o_f, s_f = gla_scan(q, k, v, la_f, s_f0)
    o_b, s_b = gla_scan(flip_seq(q), flip_seq(k), flip_seq(v), flip_seq(la_b), s_b0)
    return o_f + flip_seq(o_b), s_f, s_b


def gla_context_states(k, v, la_f, la_b):
    s0 = gla_zero_state(k.shape[0])
    s_f = gla_chunk_states(k, v, la_f, s0)[-1]
    s_b = gla_chunk_states(flip_seq(k), flip_seq(v), flip_seq(la_b), s0)[-1]
    return s_f, s_b


def short_conv(u, w, b, rows):
    bsz, L, C = u.shape
    seqs = u.reshape(bsz * rows, L // rows, C) if rows is not None else u
    pad = HY_SHORT // 2
    y = lax.conv_general_dilated(seqs, w[:, None, :].astype(u.dtype), window_strides=(1,),
                                 padding=[(pad, pad)], dimension_numbers=('NWC', 'WIO', 'NWC'),
                                 feature_group_count=C)
    return y.reshape(bsz, L, C) + b


def hyena_filters(L, f_w1, f_b1, f_fr1, f_w2, f_b2, f_fr2, f_w3):
    bands = (HY_EMB - 1) // 2
    t = jnp.linspace(0.0, 1.0, L, dtype=jnp.float32)[:, None]
    w = (2.0 * math.pi / L) * jnp.arange(L, dtype=jnp.float32)[:, None]
    f = jnp.linspace(1e-4, bands - 1, bands, dtype=jnp.float32)[None, :]
    z = jnp.concatenate([t, jnp.cos(f * w), -jnp.sin(f * w)], axis=-1)
    h = jnp.sin(f_fr1 * (z @ f_w1 + f_b1))
    h = jnp.sin(f_fr2 * (h @ f_w2 + f_b2))
    h = (h @ f_w3).astype(jnp.float32).reshape(L, 2, HY_ORDER, HY_WIDTH)
    max_decay = math.log(HY_DECAY_TARGET) / HY_FAST_DECAY
    min_decay = math.log(HY_DECAY_TARGET) / HY_SLOW_DECAY
    deltas = jnp.abs(jnp.linspace(min_decay, max_decay, HY_WIDTH, dtype=jnp.float32))
    window = jnp.exp(-t * deltas[None, :])
    return h * window[:, None, None, :]


def long_conv(z, h_fwd, h_bwd, bias):
    bsz, L, W = z.shape
    taps = jnp.concatenate([h_fwd, jnp.zeros((1, W), h_fwd.dtype), jnp.flip(h_bwd[1:], axis=0)], axis=0)
    taps = taps / (jnp.sum(jnp.abs(taps), axis=0, keepdims=True) + EPS)
    zf = z.astype(jnp.float32)
    spec = jnp.fft.rfft(zf, n=2 * L, axis=1) * jnp.fft.rfft(taps, axis=0)[None]
    y = jnp.fft.irfft(spec, n=2 * L, axis=1)[:, :L]
    return (y + bias.astype(jnp.float32) * zf).astype(z.dtype)


def hyena(u, rows, conv_w, conv_b, f_w1, f_b1, f_fr1, f_w2, f_b2, f_fr2, f_w3, bias):
    L = u.shape[1]
    u = short_conv(u, conv_w, conv_b, rows)
    v, x1, x2 = jnp.split(u, HY_ORDER + 1, axis=-1)
    h = hyena_filters(L, f_w1, f_b1, f_fr1, f_w2, f_b2, f_fr2, f_w3)
    z = v
    for o, gate in enumerate((x1, x2)):
        z = gate * long_conv(z, h[:, 0, o], h[:, 1, o], bias[o])
    return z


def mix_output(p, o_gla, rows, gla_norm_g, w_gla_out, hy_params, w_hy_out, w_out):
    bsz, L, _ = p.shape
    o = o_gla.astype(jnp.float32)
    o = o * lax.rsqrt(jnp.mean(o * o, axis=-1, keepdims=True) + EPS)
    o = (o.reshape(bsz, L, VAL_W) * gla_norm_g.astype(jnp.float32)).astype(p.dtype)
    y_gla = (o * jax.nn.silu(p[..., OFF_R:OFF_H])) @ w_gla_out
    y_hy = hyena(p[..., OFF_H:OFF_G], rows, *hy_params) @ w_hy_out
    gates = jax.nn.sigmoid(p[..., OFF_G:IN_W])
    return (gates[..., :D_MODEL] * y_gla + gates[..., D_MODEL:] * y_hy) @ w_out


def setup_inputs(seed: int = 0) -> dict:
    key = jax.random.key(seed)
    ks = iter(jax.random.split(key, 48))
    nrm = lambda shape, s: jax.random.normal(next(ks), shape, jnp.float32) * s
    D, Lr = D_MODEL, GLA_LOWRANK
    return {
        'x': nrm((BATCH, SEQ, D), 1.0),
        'c': nrm((BATCH, D), 1.0),
        'ctx': nrm((BATCH, CTX_LEN, D), 1.0),
        'c_ctx': nrm((D,), 1.0),
        'ada_w': nrm((DEPTH, D, N_MOD * D), 0.5 * D ** -0.5),
        'ada_b': nrm((DEPTH, N_MOD * D), 0.02),
        'ffn1_norm_g': 1.0 + nrm((DEPTH, D), 0.02),
        'ffn1_w_gate': nrm((DEPTH, D, D_FF), D ** -0.5),
        'ffn1_w_up': nrm((DEPTH, D, D_FF), D ** -0.5),
        'ffn1_w_down': nrm((DEPTH, D_FF, D), D_FF ** -0.5),
        'mix_norm_g': 1.0 + nrm((DEPTH, D), 0.02),
        'w_in': nrm((DEPTH, D, IN_W), D ** -0.5),
        'gla_wa_f': nrm((DEPTH, Lr, KEY_W), Lr ** -0.5),
        'gla_ba_f': nrm((DEPTH, KEY_W), 0.1),
        'gla_wa_b': nrm((DEPTH, Lr, KEY_W), Lr ** -0.5),
        'gla_ba_b': nrm((DEPTH, KEY_W), 0.1),
        'gla_norm_g': 1.0 + nrm((DEPTH, VAL_W), 0.02),
        'w_gla_out': nrm((DEPTH, VAL_W, D), VAL_W ** -0.5),
        'hy_conv_w': nrm((DEPTH, HY_SHORT, (HY_ORDER + 1) * HY_WIDTH), HY_SHORT ** -0.5),
        'hy_conv_b': nrm((DEPTH, (HY_ORDER + 1) * HY_WIDTH), 0.02),
        'hy_f_w1': nrm((DEPTH, HY_EMB, HY_HIDDEN), HY_EMB ** -0.5),
        'hy_f_b1': nrm((DEPTH, HY_HIDDEN), 0.1),
        'hy_f_freq1': 1.0 + nrm((DEPTH, HY_HIDDEN), 0.1),
        'hy_f_w2': nrm((DEPTH, HY_HIDDEN, HY_HIDDEN), HY_HIDDEN ** -0.5),
        'hy_f_b2': nrm((DEPTH, HY_HIDDEN), 0.1),
        'hy_f_freq2': 1.0 + nrm((DEPTH, HY_HIDDEN), 0.1),
        'hy_f_w3': nrm((DEPTH, HY_HIDDEN, 2 * HY_ORDER * HY_WIDTH), HY_HIDDEN ** -0.5),
        'hy_bias': nrm((DEPTH, HY_ORDER, HY_WIDTH), 0.5),
        'w_hy_out': nrm((DEPTH, HY_WIDTH, D), HY_WIDTH ** -0.5),
        'w_out': nrm((DEPTH, D, D), D ** -0.5),
        'ffn2_norm_g': 1.0 + nrm((DEPTH, D), 0.02),
        'ffn2_w_gate': nrm((DEPTH, D, D_FF), D ** -0.5),
        'ffn2_w_up': nrm((DEPTH, D, D_FF), D ** -0.5),
        'ffn2_w_down': nrm((DEPTH, D_FF, D), D_FF ** -0.5),
        'final_norm_g': 1.0 + nrm((D,), 0.02),
    }


def reference(x, c, ctx, c_ctx, ada_w, ada_b, ffn1_norm_g, ffn1_w_gate, ffn1_w_up, ffn1_w_down,
              mix_norm_g, w_in, gla_wa_f, gla_ba_f, gla_wa_b, gla_ba_b, gla_norm_g, w_gla_out,
              hy_conv_w, hy_conv_b, hy_f_w1, hy_f_b1, hy_f_freq1, hy_f_w2, hy_f_b2, hy_f_freq2, hy_f_w3,
              hy_bias, w_hy_out, w_out, ffn2_norm_g, ffn2_w_gate, ffn2_w_up, ffn2_w_down, final_norm_g):
    rows = x.shape[1] // GRID_W
    xl, xc = x, ctx
    for i in range(DEPTH):
        last = i == DEPTH - 1
        ml = jnp.split((jax.nn.silu(c) @ ada_w[i] + ada_b[i])[:, None, :], N_MOD, axis=-1)
        mc = jnp.split((jax.nn.silu(c_ctx) @ ada_w[i] + ada_b[i])[None, None, :], N_MOD, axis=-1)
        ffn1 = (ffn1_norm_g[i], ffn1_w_gate[i], ffn1_w_up[i], ffn1_w_down[i])
        ffn2 = (ffn2_norm_g[i], ffn2_w_gate[i], ffn2_w_up[i], ffn2_w_down[i])
        gla_p = (gla_wa_f[i], gla_ba_f[i], gla_wa_b[i], gla_ba_b[i])
        hy_p = (hy_conv_w[i], hy_conv_b[i], hy_f_w1[i], hy_f_b1[i], hy_f_freq1[i], hy_f_w2[i],
                hy_f_b2[i], hy_f_freq2[i], hy_f_w3[i], hy_bias[i])

        xl = ffn_sublayer(xl, ml[0:3], *ffn1)
        xc = ffn_sublayer(xc, mc[0:3], *ffn1)

        hl = modulate(rms_norm(xl, mix_norm_g[i]), ml[3], ml[4])
        hc = modulate(rms_norm(xc, mix_norm_g[i]), mc[3], mc[4])
        pl = hl @ w_in[i]
        if last:
            kc, vc, laf_c, lab_c = gla_inputs(hc @ w_in[i][:, :OFF_Q], *gla_p)
            s_f, s_b = gla_context_states(kc, vc, laf_c, lab_c)
        else:
            pc = hc @ w_in[i]
            kc, vc, laf_c, lab_c = gla_inputs(pc, *gla_p)
            zero = gla_zero_state(xc.shape[0])
            o_c, s_f, s_b = gla_bidir(gla_query(pc), kc, vc, laf_c, lab_c, zero, zero)
            xc = xc + mc[5] * mix_output(pc, o_c, None, gla_norm_g[i], w_gla_out[i], hy_p, w_hy_out[i], w_out[i])
            xc = ffn_sublayer(xc, mc[6:9], *ffn2)
        kl, vl, laf_l, lab_l = gla_inputs(pl, *gla_p)
        o_l, _, _ = gla_bidir(gla_query(pl), kl, vl, laf_l, lab_l, s_f, s_b)
        xl = xl + ml[5] * mix_output(pl, o_l, rows, gla_norm_g[i], w_gla_out[i], hy_p, w_hy_out[i], w_out[i])

        xl = ffn_sublayer(xl, ml[6:9], *ffn2)
    return rms_norm(xl, final_norm_g)
```

```cpp
#include <hip/hip_runtime.h>
#include <hip/hip_cooperative_groups.h>
#include <cstdio>
namespace cg = cooperative_groups;

#define DEVI __device__ __forceinline__
#define LAS __attribute__((address_space(3)))
typedef unsigned short bf16_t;
typedef short bf16x8 __attribute__((ext_vector_type(8)));
typedef float f32x4 __attribute__((ext_vector_type(4)));
typedef float f32x2 __attribute__((ext_vector_type(2)));
typedef unsigned u32x4 __attribute__((ext_vector_type(4)));
typedef unsigned u32x2 __attribute__((ext_vector_type(2)));

constexpr int MLAT = 16384, MTOT = 17408, DM = 1024, DFF = 2816, INW = 8224;
constexpr int PGW = 3328;
constexpr size_t U = (size_t)MTOT * 1024 * 2;
constexpr size_t WS_X = 0;
constexpr size_t WS_R = (size_t)MTOT * 1024 * 4;
constexpr size_t WS_W = WS_R + 6 * U;
constexpr size_t W_GU1 = 0, W_D1 = 11534336, W_IN = 17301504, W_GO = 34603008, W_HO = 36700160, W_O = 38797312, W_GU2 = 40894464, W_D2 = 52428800, W_END = 58195968;
constexpr size_t WS_MOD = WS_W + W_END;
constexpr size_t WS_H2 = WS_MOD + 2 * 5 * 9216 * 4;
constexpr size_t WS_INVN = WS_H2 + (size_t)2 * 4352 * 64 * 4;
constexpr size_t WS_BAR = WS_INVN + 8192;
constexpr size_t WS_END = WS_BAR + 16384;
constexpr size_t R_ACT = 0, R_PG = 0, R_OB = 115867648, R_HCH = 0, R_G = 3 * U, R_OF = 5 * U, R_T1 = U, R_AM = 0;
constexpr int LDS_BYTES = 147456;
#ifndef GCONST
#define GCONST 0
#endif
#ifndef LIMIT
#define LIMIT 127
#endif

struct Params { const float* in[35]; float* out; unsigned char* ws; };

DEVI int otid() { int t = threadIdx.x; asm volatile("" : "+v"(t)); return t; }
typedef __bf16 bf16x2_t __attribute__((ext_vector_type(2)));
DEVI unsigned cvt_pk_bf16(float lo, float hi) { bf16x2_t v = {(__bf16)lo, (__bf16)hi}; return __builtin_bit_cast(unsigned, v); }
DEVI bf16_t f2bf(float f) { return (bf16_t)(cvt_pk_bf16(f, 0.f) & 0xffffu); }
DEVI float bf2f(bf16_t b) { return __uint_as_float(((unsigned)b) << 16); }
DEVI float bflo(unsigned w) { return __uint_as_float(w << 16); }
DEVI float bfhi(unsigned w) { return __uint_as_float(w & 0xffff0000u); }
DEVI float silu_f(float x) { return x * __builtin_amdgcn_rcpf(1.f + __expf(-x)); }
DEVI float sigmoid_f(float x) { return __builtin_amdgcn_rcpf(1.f + __expf(-x)); }
DEVI void unpack8(u32x4 w, float* o) { o[0] = bflo(w.x); o[1] = bfhi(w.x); o[2] = bflo(w.y); o[3] = bfhi(w.y); o[4] = bflo(w.z); o[5] = bfhi(w.z); o[6] = bflo(w.w); o[7] = bfhi(w.w); }
DEVI u32x4 pack8(const float* v) { u32x4 w; w.x = cvt_pk_bf16(v[0], v[1]); w.y = cvt_pk_bf16(v[2], v[3]); w.z = cvt_pk_bf16(v[4], v[5]); w.w = cvt_pk_bf16(v[6], v[7]); return w; }

namespace pg8 {
constexpr int BM = 256, BK = 64, HALF = 128, HTB = HALF * BK * 2, STAGE_BYTES = 8 * HTB, NXCD = 8, WGM = 8;
DEVI int lds_byte(int r, int c) { const int st = (r >> 4) * 2 + (c >> 5), rr = r & 15, cc = c & 31, ob = rr * 64 + cc * 2; return st * 1024 + (ob ^ (((ob >> 9) & 1) << 5)); }
DEVI void stage_rc(int b, int& R, int& C) { const int st = b / 1024, sb = b % 1024, swz = sb ^ (((sb >> 9) & 1) << 5); R = (st >> 1) * 16 + swz / 64; C = (st & 1) * 32 + (swz % 64) / 2; }
DEVI int perm32(int rho) { const int n = rho >> 4, i = rho & 15; return 8 * (i >> 2) + 4 * n + (i & 3); }
struct Unit { int pm, pn, k0, nt; };
struct Gemm { const bf16_t* A; const bf16_t* Bt; int M, N, K; };
struct StaticOrder {
    int nM, nN, nwg, G, c, ntf;
    DEVI void init(int M, int N, int K, int G_, int c_) { nM = M / BM; nN = N / BM; nwg = nM * nN; G = G_; c = c_; ntf = K / BK; }
    DEVI bool next(int i, Unit& u) const {
        const long L = (long)i * G + c; if (L >= nwg) return false;
        int wgid = (int)L; { const int q = nwg / NXCD, r = nwg % NXCD, xcd = wgid % NXCD, off = wgid / NXCD; wgid = (xcd < r ? xcd * (q + 1) : r * (q + 1) + (xcd - r) * q) + off; }
        const int nig = WGM * nN, gid = wgid / nig, fm = gid * WGM, gsz = (nM - fm) < WGM ? (nM - fm) : WGM;
        u.pm = fm + ((wgid % nig) % gsz); u.pn = (wgid % nig) / gsz; u.k0 = 0; u.nt = ntf; return true;
    }
};
struct SplitOrder {
    StaticOrder full; int nN, nsl, nsub, nMf;
    DEVI void init(int Mfull, int Mtot, int N, int K, int G_, int c_) { full.init(Mfull, N, K, G_, c_); nN = N / BM; nMf = Mfull / BM; nsl = K / 256; nsub = ((Mtot - Mfull) / BM) * nN * nsl; }
    DEVI bool next(int i, Unit& u) const {
        const long L = (long)i * full.G + full.c; if (L < full.nwg) return full.next(i, u);
        const int j = (int)(L - full.nwg); if (j >= nsub) return false;
        const int sl = j % nsl, t = j / nsl; u.pn = t % nN; u.pm = nMf + t / nN; u.k0 = sl * 256; u.nt = 4; return true;
    }
};

template <class Epi, class Sched>
DEVI void gemm_phase(LAS unsigned char* lds, const Gemm g, const Sched& S, const Epi& E) {
    const int tid = otid(), wid = __builtin_amdgcn_readfirstlane(tid >> 6), lane = tid & 63, wr = wid >> 2, wc = wid & 3, fr = lane & 15, fq = lane >> 4;
    const int K = g.K;
    unsigned voffA[2], voffB[2];
#pragma unroll
    for (int i = 0; i < 2; ++i) { int R, C; stage_rc(tid * 16 + i * 8192, R, C); const int Rb = Epi::PERM ? ((R & ~31) + perm32(R & 31)) : R;
        voffA[i] = (unsigned)(R * K + C) * 2u; voffB[i] = (unsigned)(Rb * K + C) * 2u; }
    const size_t kstep = (size_t)(BK * 2);
    const size_t hstep = (size_t)HALF * K * 2;
    const size_t tstep = 2 * hstep;
    const unsigned ldsw = (unsigned)wid * 1024u;
    const int aoff = lds_byte(wr * 64 + fr, fq * 8), boff = lds_byte(wc * 32 + fr, fq * 8);
#define PG8_SA(b, h) (((b) * 2 + (h)) * HTB)
#define PG8_SB(b, h) ((4 + (b) * 2 + (h)) * HTB)
#define PG8_STAGE(bufoff, gbase, voff) do { _Pragma("unroll") for (int _i = 0; _i < 2; ++_i) \
        __builtin_amdgcn_global_load_lds((const unsigned*)((const char*)(gbase) + (voff)[_i]), (LAS unsigned*)(lds + (bufoff) + ldsw + _i * 8192), 16, 0, 0); } while (0)
#define PG8_LDA(dst, b, h) do { _Pragma("unroll") for (int m = 0; m < 4; ++m) _Pragma("unroll") for (int k = 0; k < 2; ++k) dst[m][k] = *(const LAS bf16x8*)(lds + PG8_SA(b, h) + aoff + m * 2048 + k * 1024); } while (0)
#define PG8_LDB(dst, b, h) do { _Pragma("unroll") for (int n = 0; n < 2; ++n) _Pragma("unroll") for (int k = 0; k < 2; ++k) dst[n][k] = *(const LAS bf16x8*)(lds + PG8_SB(b, h) + boff + n * 2048 + k * 1024); } while (0)
#define PG8_MMA(ai, bj, At, Bt) do { __builtin_amdgcn_s_setprio(1); _Pragma("unroll") for (int m = 0; m < 4; ++m) _Pragma("unroll") for (int n = 0; n < 2; ++n) _Pragma("unroll") for (int k = 0; k < 2; ++k) \
        acc[ai][bj][m][n] = __builtin_amdgcn_mfma_f32_16x16x32_bf16(Bt[n][k], At[m][k], acc[ai][bj][m][n], 0, 0, 0); __builtin_amdgcn_s_setprio(0); } while (0)
#define PG8_WAIT_V(n) asm volatile("s_waitcnt vmcnt(" #n ")" ::: "memory")
#define PG8_WAIT_L(n) asm volatile("s_waitcnt lgkmcnt(" #n ")" ::: "memory")
#define PG8_BAR __builtin_amdgcn_s_barrier()
#define PG8_SCHED __builtin_amdgcn_sched_barrier(0)
    Unit cur, nxt; int ui = 0;
    if (!S.next(0, cur)) return;
    f32x4 acc[2][2][4][2];
#pragma unroll
    for (int a = 0; a < 2; ++a)
#pragma unroll
        for (int b = 0; b < 2; ++b)
#pragma unroll
            for (int m = 0; m < 4; ++m)
#pragma unroll
                for (int n = 0; n < 2; ++n) acc[a][b][m][n] = (f32x4){0.f, 0.f, 0.f, 0.f};
    bf16x8 At[4][2], B0[2][2], B1[2][2];
    const char* cA = (const char*)g.A + (size_t)cur.pm * tstep + (size_t)cur.k0 * 2; const char* cB = (const char*)g.Bt + (size_t)cur.pn * tstep + (size_t)cur.k0 * 2;
    PG8_STAGE(PG8_SB(0, 0), cB, voffB); PG8_STAGE(PG8_SA(0, 0), cA, voffA); PG8_STAGE(PG8_SB(0, 1), cB + hstep, voffB); PG8_STAGE(PG8_SA(0, 1), cA + hstep, voffA);
    if (wr == 1) PG8_BAR;
    PG8_WAIT_V(4); PG8_BAR;
    PG8_STAGE(PG8_SB(1, 0), cB + kstep, voffB); PG8_STAGE(PG8_SA(1, 0), cA + kstep, voffA); PG8_STAGE(PG8_SB(1, 1), cB + hstep + kstep, voffB);
    PG8_WAIT_V(6); PG8_BAR;
    for (;;) {
        const bool has_next = S.next(ui + 1, nxt);
        const char* nA = has_next ? (const char*)g.A + (size_t)nxt.pm * tstep + (size_t)nxt.k0 * 2 : cA; const char* nB = has_next ? (const char*)g.Bt + (size_t)nxt.pn * tstep + (size_t)nxt.k0 * 2 : cB;
        const int nt = cur.nt;
        for (int t = 0; t < nt; t += 2) {
            const bool last = (t == nt - 2);
            const char* a1 = cA + (size_t)(t + 1) * kstep;
            const char* a2 = last ? nA : cA + (size_t)(t + 2) * kstep; const char* b2 = last ? nB : cB + (size_t)(t + 2) * kstep;
            const char* a3 = a2 + kstep; const char* b3 = b2 + kstep;
            PG8_LDB(B0, 0, 0); PG8_SCHED; PG8_LDA(At, 0, 0); PG8_STAGE(PG8_SA(1, 1), a1 + hstep, voffA);
            PG8_WAIT_L(8); PG8_BAR; PG8_WAIT_L(0); PG8_MMA(0, 0, At, B0); PG8_BAR; PG8_SCHED;
            PG8_LDB(B1, 0, 1); PG8_STAGE(PG8_SB(0, 0), b2, voffB);
            PG8_BAR; PG8_WAIT_L(0); PG8_MMA(0, 1, At, B1); PG8_BAR;
            PG8_LDA(At, 0, 1); PG8_STAGE(PG8_SA(0, 0), a2, voffA);
            PG8_BAR; PG8_WAIT_L(0); PG8_MMA(1, 0, At, B0); PG8_BAR; PG8_SCHED;
            PG8_STAGE(PG8_SB(0, 1), b2 + hstep, voffB);
            PG8_WAIT_V(6); PG8_BAR; PG8_MMA(1, 1, At, B1); PG8_BAR;
            PG8_LDB(B0, 1, 0); PG8_SCHED; PG8_LDA(At, 1, 0); PG8_STAGE(PG8_SA(0, 1), a2 + hstep, voffA);
            PG8_WAIT_L(8); PG8_BAR; PG8_WAIT_L(0); PG8_MMA(0, 0, At, B0); PG8_BAR; PG8_SCHED;
            PG8_LDB(B1, 1, 1); PG8_STAGE(PG8_SB(1, 0), b3, voffB);
            PG8_BAR; PG8_WAIT_L(0); PG8_MMA(0, 1, At, B1); PG8_BAR;
            PG8_LDA(At, 1, 1); PG8_STAGE(PG8_SA(1, 0), a3, voffA);
            PG8_BAR; PG8_WAIT_L(0); PG8_MMA(1, 0, At, B0); PG8_BAR; PG8_SCHED;
            PG8_STAGE(PG8_SB(1, 1), b3 + hstep, voffB);
            PG8_WAIT_V(6); PG8_BAR; PG8_MMA(1, 1, At, B1); PG8_BAR;
        }
        E(acc, cur, wr, wc, fr, fq);
        if (!has_next) break;
#pragma unroll
        for (int a = 0; a < 2; ++a)
#pragma unroll
            for (int b = 0; b < 2; ++b)
#pragma unroll
                for (int m = 0; m < 4; ++m)
#pragma unroll
                    for (int n = 0; n < 2; ++n) acc[a][b][m][n] = (f32x4){0.f, 0.f, 0.f, 0.f};
        cur = nxt; cA = nA; cB = nB; ++ui;
    }
    PG8_WAIT_V(0);
    if (wr == 0) PG8_BAR;
    PG8_BAR;
#undef PG8_SA
#undef PG8_SB
#undef PG8_STAGE
#undef PG8_LDA
#undef PG8_LDB
#undef PG8_MMA
#undef PG8_WAIT_V
#undef PG8_WAIT_L
#undef PG8_BAR
#undef PG8_SCHED
}
}
using pg8::Unit; using pg8::Gemm; using pg8::StaticOrder; using pg8::HALF; using pg8::BM;
typedef f32x4 AccT[2][2][4][2];

struct EpiSwiglu {
    static constexpr bool PERM = true; bf16_t* O;
    DEVI void operator()(const AccT& acc, const Unit& u, int wr, int wc, int fr, int fq) const {
        const int row0 = u.pm * BM + wr * 64 + fr, j0 = u.pn * HALF + wc * 32 + 8 * fq;
#pragma unroll
        for (int ai = 0; ai < 2; ++ai)
#pragma unroll
            for (int m = 0; m < 4; ++m) { bf16_t* rowp = O + (size_t)(row0 + ai * HALF + m * 16) * DFF + j0;
                const f32x4 g0 = acc[ai][0][m][0], g1 = acc[ai][0][m][1], u0 = acc[ai][1][m][0], u1 = acc[ai][1][m][1];
                u32x4 w; w.x = cvt_pk_bf16(silu_f(g0[0]) * u0[0], silu_f(g0[1]) * u0[1]); w.y = cvt_pk_bf16(silu_f(g0[2]) * u0[2], silu_f(g0[3]) * u0[3]);
                w.z = cvt_pk_bf16(silu_f(g1[0]) * u1[0], silu_f(g1[1]) * u1[1]); w.w = cvt_pk_bf16(silu_f(g1[2]) * u1[2], silu_f(g1[3]) * u1[3]);
                *(u32x4*)rowp = w; }
    }
};
struct EpiResid {
    static constexpr bool PERM = false; float* X; const float* Xin; const float* mod; int idx; float scale; float* part;
    DEVI void operator()(const AccT& acc, const Unit& u, int wr, int wc, int fr, int fq) const {
        const int row0 = u.pm * BM + wr * 64 + fr, col0 = u.pn * BM + wc * 32 + 4 * fq;
        const int brow = u.pm < 64 ? (u.pm >> 4) : 4; const bool split = u.pm >= 64;
        f32x4 gv[2][2];
#pragma unroll
        for (int bj = 0; bj < 2; ++bj)
#pragma unroll
            for (int n = 0; n < 2; ++n) gv[bj][n] = *(const f32x4*)(mod + brow * 9216 + idx * 1024 + col0 + bj * HALF + n * 16) * scale;
        if (split) {
#pragma unroll
            for (int ai = 0; ai < 2; ++ai)
#pragma unroll
                for (int m = 0; m < 4; ++m) { float* pp = part + ((size_t)(u.k0 >> 8) * 1024 + (size_t)(row0 + ai * HALF + m * 16 - MLAT)) * DM + col0;
#pragma unroll
                    for (int bj = 0; bj < 2; ++bj)
#pragma unroll
                        for (int n = 0; n < 2; ++n) *(f32x4*)(pp + bj * HALF + n * 16) = gv[bj][n] * acc[ai][bj][m][n]; }
        } else {
#pragma unroll
            for (int ai = 0; ai < 2; ++ai) { f32x4 xv[4][2][2];
#pragma unroll
                for (int m = 0; m < 4; ++m) { const float* rinp = Xin + (size_t)(row0 + ai * HALF + m * 16) * DM + col0;
#pragma unroll
                    for (int bj = 0; bj < 2; ++bj)
#pragma unroll
                        for (int n = 0; n < 2; ++n) xv[m][bj][n] = *(const f32x4*)(rinp + bj * HALF + n * 16); }
                asm volatile("" ::: "memory");
#pragma unroll
                for (int m = 0; m < 4; ++m) { float* rowp = X + (size_t)(row0 + ai * HALF + m * 16) * DM + col0;
#pragma unroll
                    for (int bj = 0; bj < 2; ++bj)
#pragma unroll
                        for (int n = 0; n < 2; ++n) *(f32x4*)(rowp + bj * HALF + n * 16) = xv[m][bj][n] + gv[bj][n] * acc[ai][bj][m][n]; }
                asm volatile("" ::: "memory"); }
        }
    }
};
template <int ACT> struct EpiBf16 {
    static constexpr bool PERM = true; bf16_t* O; int ldc;
    DEVI void operator()(const AccT& acc, const Unit& u, int wr, int wc, int fr, int fq) const {
        const int row0 = u.pm * BM + wr * 64 + fr, col0 = u.pn * BM + wc * 32 + 8 * fq;
#pragma unroll
        for (int ai = 0; ai < 2; ++ai)
#pragma unroll
            for (int m = 0; m < 4; ++m) { bf16_t* rowp = O + (size_t)(row0 + ai * HALF + m * 16) * ldc + col0;
#pragma unroll
                for (int bj = 0; bj < 2; ++bj) { f32x4 v0 = acc[ai][bj][m][0], v1 = acc[ai][bj][m][1];
                    if (ACT == 1) {
#pragma unroll
                        for (int j = 0; j < 4; ++j) { v0[j] = sigmoid_f(v0[j]); v1[j] = sigmoid_f(v1[j]); } }
                    u32x4 w; w.x = cvt_pk_bf16(v0[0], v0[1]); w.y = cvt_pk_bf16(v0[2], v0[3]); w.z = cvt_pk_bf16(v1[0], v1[1]); w.w = cvt_pk_bf16(v1[2], v1[3]);
                    *(u32x4*)(rowp + bj * HALF) = w; } }
    }
};
struct EpiGateA {
    static constexpr bool PERM = true; float* T1; const bf16_t* G;
    DEVI void operator()(const AccT& acc, const Unit& u, int wr, int wc, int fr, int fq) const {
        const int row0 = u.pm * BM + wr * 64 + fr, col0 = u.pn * BM + wc * 32 + 8 * fq;
#pragma unroll
        for (int ai = 0; ai < 2; ++ai) { u32x4 gw[4][2];
#pragma unroll
            for (int m = 0; m < 4; ++m) { const size_t row = (size_t)(row0 + ai * HALF + m * 16);
#pragma unroll
                for (int bj = 0; bj < 2; ++bj) gw[m][bj] = GCONST ? (u32x4){0x3f003f00u, 0x3f003f00u, 0x3f003f00u, 0x3f003f00u} : *(const u32x4*)(G + row * 2048 + col0 + bj * HALF); }
            asm volatile("" ::: "memory");
#pragma unroll
            for (int m = 0; m < 4; ++m) { const size_t row = (size_t)(row0 + ai * HALF + m * 16);
#pragma unroll
                for (int bj = 0; bj < 2; ++bj) { const u32x4 g4 = gw[m][bj]; float* tp = T1 + row * DM + col0 + bj * HALF;
                    *(f32x4*)tp = (f32x4){bflo(g4.x), bfhi(g4.x), bflo(g4.y), bfhi(g4.y)} * acc[ai][bj][m][0];
                    *(f32x4*)(tp + 4) = (f32x4){bflo(g4.z), bfhi(g4.z), bflo(g4.w), bfhi(g4.w)} * acc[ai][bj][m][1]; } }
            asm volatile("" ::: "memory"); }
    }
};
struct EpiGateB {
    static constexpr bool PERM = true; const float* T1; const bf16_t* G; bf16_t* Am;
    DEVI void operator()(const AccT& acc, const Unit& u, int wr, int wc, int fr, int fq) const {
        const int row0 = u.pm * BM + wr * 64 + fr, col0 = u.pn * BM + wc * 32 + 8 * fq;
#pragma unroll
        for (int ai = 0; ai < 2; ++ai)
#pragma unroll
            for (int mp = 0; mp < 2; ++mp) { u32x4 gw[2][2]; f32x4 tv[2][2][2];
#pragma unroll
                for (int mm = 0; mm < 2; ++mm) { const size_t row = (size_t)(row0 + ai * HALF + (mp * 2 + mm) * 16);
#pragma unroll
                    for (int bj = 0; bj < 2; ++bj) { const int c = col0 + bj * HALF; gw[mm][bj] = GCONST ? (u32x4){0x3f003f00u, 0x3f003f00u, 0x3f003f00u, 0x3f003f00u} : *(const u32x4*)(G + row * 2048 + 1024 + c);
                        tv[mm][bj][0] = *(const f32x4*)(T1 + row * DM + c); tv[mm][bj][1] = *(const f32x4*)(T1 + row * DM + c + 4); } }
                asm volatile("" ::: "memory");
#pragma unroll
                for (int mm = 0; mm < 2; ++mm) { const int m = mp * 2 + mm; const size_t row = (size_t)(row0 + ai * HALF + m * 16);
#pragma unroll
                    for (int bj = 0; bj < 2; ++bj) { const int c = col0 + bj * HALF; const u32x4 g4 = gw[mm][bj];
                        const f32x4 v0 = tv[mm][bj][0] + (f32x4){bflo(g4.x), bfhi(g4.x), bflo(g4.y), bfhi(g4.y)} * acc[ai][bj][m][0];
                        const f32x4 v1 = tv[mm][bj][1] + (f32x4){bflo(g4.z), bfhi(g4.z), bflo(g4.w), bfhi(g4.w)} * acc[ai][bj][m][1];
                        u32x4 w; w.x = cvt_pk_bf16(v0[0], v0[1]); w.y = cvt_pk_bf16(v0[2], v0[3]); w.z = cvt_pk_bf16(v1[0], v1[1]); w.w = cvt_pk_bf16(v1[2], v1[3]);
                        *(u32x4*)(Am + row * DM + c) = w; } }
                asm volatile("" ::: "memory"); }
    }
};

template <class Epi> DEVI void run_gemm(unsigned char* shm, const bf16_t* A, const bf16_t* Bt, int M, int N, int K, const Epi& E, bool rev = false) {
    Gemm g; g.A = A; g.Bt = Bt; g.M = M; g.N = N; g.K = K;
    StaticOrder S; S.init(M, N, K, (int)gridDim.x, rev ? (int)(gridDim.x - 1 - blockIdx.x) : (int)blockIdx.x);
    pg8::gemm_phase<Epi, StaticOrder>((LAS unsigned char*)shm, g, S, E);
}
template <class Epi> DEVI void run_gemm_split(unsigned char* shm, const bf16_t* A, const bf16_t* Bt, int Mfull, int Mtot, int N, int K, const Epi& E) {
    Gemm g; g.A = A; g.Bt = Bt; g.M = Mtot; g.N = N; g.K = K;
    pg8::SplitOrder S; S.init(Mfull, Mtot, N, K, (int)gridDim.x, (int)blockIdx.x);
    pg8::gemm_phase<Epi, pg8::SplitOrder>((LAS unsigned char*)shm, g, S, E);
}

DEVI float shx(float v, int lane, int m) { return __int_as_float(__builtin_amdgcn_ds_bpermute((lane ^ m) << 2, __float_as_int(v))); }
DEVI float wave_sum(float v, int lane) {
#pragma unroll
    for (int o = 32; o >= 1; o >>= 1) v += shx(v, lane, o);
    return v;
}

DEVI void norm_phase(float* X, bf16_t* Hn, const float* g, const float* modl, int ish, int isc, int M, const float* part, int nsl, const float* xlat = nullptr) {
    const int tid_ = otid(), lane = tid_ & 63, wid = tid_ >> 6;
    f32x4 gg[4];
#pragma unroll
    for (int i = 0; i < 4; ++i) gg[i] = *(const f32x4*)(g + i * 256 + lane * 4);
    for (int row = blockIdx.x * 8 + wid; row < M; row += gridDim.x * 8) {
        float* xr = X + (size_t)row * DM; const float* xs = (xlat && row < MLAT) ? xlat + (size_t)row * DM : xr; f32x4 v[4], sh[4], sc[4]; float ss = 0.f;
        const int brow = row < MLAT ? (row >> 12) : 4; const float* mb = modl + brow * 9216;
#pragma unroll
        for (int i = 0; i < 4; ++i) { v[i] = *(const f32x4*)(xs + i * 256 + lane * 4); sh[i] = *(const f32x4*)(mb + ish * 1024 + i * 256 + lane * 4); sc[i] = *(const f32x4*)(mb + isc * 1024 + i * 256 + lane * 4); }
        if (row >= MLAT && nsl > 0) {
            for (int s0 = 0; s0 < nsl; s0 += 4) {
                f32x4 t[4][4];
#pragma unroll
                for (int q = 0; q < 4; ++q) { const int sl = s0 + q < nsl ? s0 + q : nsl - 1; const float* pr = part + ((size_t)sl * 1024 + (row - MLAT)) * DM;
#pragma unroll
                    for (int i = 0; i < 4; ++i) t[q][i] = *(const f32x4*)(pr + i * 256 + lane * 4); }
                asm volatile("" ::: "memory");
#pragma unroll
                for (int q = 0; q < 4; ++q) if (s0 + q < nsl) {
#pragma unroll
                    for (int i = 0; i < 4; ++i) v[i] += t[q][i]; } }
#pragma unroll
            for (int i = 0; i < 4; ++i) *(f32x4*)(xr + i * 256 + lane * 4) = v[i];
        }
#pragma unroll
        for (int i = 0; i < 4; ++i) ss += v[i][0] * v[i][0] + v[i][1] * v[i][1] + v[i][2] * v[i][2] + v[i][3] * v[i][3];
        ss = wave_sum(ss, lane); const float rstd = rsqrtf(ss * (1.f / 1024.f) + 1e-6f);
#pragma unroll
        for (int i = 0; i < 4; ++i) { const int c = i * 256 + lane * 4;
            const f32x4 h = (v[i] * rstd * gg[i]) * (sc[i] + 1.f) + sh[i]; u32x2 w; w.x = cvt_pk_bf16(h[0], h[1]); w.y = cvt_pk_bf16(h[2], h[3]); *(u32x2*)(Hn + (size_t)row * DM + c) = w; }
    }
}
DEVI void final_norm_phase(const float* X, float* out, const float* g) {
    const int tid_ = otid(), lane = tid_ & 63, wid = tid_ >> 6;
    f32x4 gg[4];
#pragma unroll
    for (int i = 0; i < 4; ++i) gg[i] = *(const f32x4*)(g + i * 256 + lane * 4);
    for (int row = blockIdx.x * 8 + wid; row < MLAT; row += gridDim.x * 8) {
        const float* xr = X + (size_t)row * DM; f32x4 v[4]; float ss = 0.f;
#pragma unroll
        for (int i = 0; i < 4; ++i) { v[i] = *(const f32x4*)(xr + i * 256 + lane * 4); ss += v[i][0] * v[i][0] + v[i][1] * v[i][1] + v[i][2] * v[i][2] + v[i][3] * v[i][3]; }
        ss = wave_sum(ss, lane); const float rstd = rsqrtf(ss * (1.f / 1024.f) + 1e-6f);
#pragma unroll
        for (int i = 0; i < 4; ++i) { const int c = i * 256 + lane * 4; *(f32x4*)(out + (size_t)row * DM + c) = v[i] * rstd * gg[i]; }
    }
}

DEVI void xinit_phase(const Params& p, float* X) {
    const size_t n4b = (size_t)1024 * DM / 4;
    const f32x4* cs = (const f32x4*)p.in[2]; f32x4* xd = (f32x4*)(X + (size_t)MLAT * DM);
    const int tid_ = otid();
    for (size_t i = (size_t)blockIdx.x * 512 + tid_; i < n4b; i += (size_t)gridDim.x * 512) xd[i] = cs[i];
}
DEVI void mod_phase(const Params& p, float* MOD, unsigned char* shm) {
    float* s = (float*)shm;
    float* red = (float*)(shm + 20480);
    const int tid = otid();
    { float cv[10];
#pragma unroll
      for (int q = 0; q < 8; ++q) cv[q] = p.in[1][tid + 512 * q];
#pragma unroll
      for (int q = 0; q < 2; ++q) cv[8 + q] = p.in[3][tid + 512 * q];
#pragma unroll
      for (int q = 0; q < 10; ++q) s[tid + 512 * q] = silu_f(cv[q]); }
    __syncthreads();
    for (int job = blockIdx.x; job < 288; job += gridDim.x) {
        const int layer = job / 144, col0 = (job % 144) * 64;
        const int kg = tid >> 6, cl = tid & 63; const float* w = p.in[4] + (size_t)layer * 1024 * 9216 + col0 + cl;
        float a0 = 0.f, a1 = 0.f, a2 = 0.f, a3 = 0.f, a4 = 0.f;
#pragma unroll 16
        for (int k = kg * 128; k < kg * 128 + 128; ++k) { const float wv = w[(size_t)k * 9216]; a0 += s[k] * wv; a1 += s[1024 + k] * wv; a2 += s[2048 + k] * wv; a3 += s[3072 + k] * wv; a4 += s[4096 + k] * wv; }
        red[(kg * 5 + 0) * 64 + cl] = a0; red[(kg * 5 + 1) * 64 + cl] = a1; red[(kg * 5 + 2) * 64 + cl] = a2; red[(kg * 5 + 3) * 64 + cl] = a3; red[(kg * 5 + 4) * 64 + cl] = a4;
        __syncthreads();
        if (tid < 320) { const int r = tid >> 6; float t = p.in[5][layer * 9216 + col0 + cl];
            for (int q = 0; q < 8; ++q) t += red[(q * 5 + r) * 64 + cl];
            MOD[(layer * 5 + r) * 9216 + col0 + cl] = t; }
        __syncthreads();
    }
}
DEVI void h2_phase(const Params& p, float* H2, unsigned char* shm) {
    const int tid = otid(), lane = tid & 63, wid = tid >> 6;
    float* zb = (float*)shm + wid * 128; float* hb = zb + 64;
    for (int job = (blockIdx.x + 64) % gridDim.x; job < 1088; job += gridDim.x) {
        const int layer = job / 544, rem = (job % 544) * 8 + wid;
        const int L = rem < 4096 ? 4096 : 256, t = rem < 4096 ? rem : rem - 4096;
        const float wv = (6.283185307179586f / (float)L) * (float)t;
        if (lane < 33) { float z;
            if (lane == 0) z = (float)t / (float)(L - 1);
            else { const int i = (lane - 1) & 15; const float f = 1e-4f + (float)i * ((15.f - 1e-4f) / 15.f); const float a = f * wv; z = lane <= 16 ? cosf(a) : -sinf(a); }
            zb[lane] = z; }
        __syncthreads();
        const float* w1 = p.in[20] + layer * 33 * 64; float a = p.in[21][layer * 64 + lane];
        for (int e = 0; e < 33; ++e) a += zb[e] * w1[e * 64 + lane];
        hb[lane] = sinf(p.in[22][layer * 64 + lane] * a);
        __syncthreads();
        const float* w2 = p.in[23] + layer * 64 * 64; float b = p.in[24][layer * 64 + lane];
        for (int e = 0; e < 64; ++e) b += hb[e] * w2[e * 64 + lane];
        H2[((size_t)layer * 4352 + rem) * 64 + lane] = sinf(p.in[25][layer * 64 + lane] * b);
        __syncthreads();
    }
}
DEVI int win_src(int row) {
    if (row < 1536) return row;
    if (row < 2048) return 1568 + (row - 1536);
    if (row < 3072) return 2080 + (row - 2048);
    if (row < 3104) return 1536 + (row - 3072);
    if (row < 3328) return -1;
    if (row < 6400) return 3104 + (row - 3328);
    return 6176 + (row - 6400);
}
DEVI void convert_phase(const Params& p, int layer, unsigned char* W, unsigned char* shm) {
    float* tile = (float*)shm;
    const int tid = otid();
    for (int job = (blockIdx.x + 240) % gridDim.x; job < 1776; job += gridDim.x) {
        int m, tr, tk, K; bf16_t* dst;
        if (job < 352) { m = 0; tr = job >> 2; tk = job & 3; K = 1024; dst = (bf16_t*)(W + W_GU1); }
        else if (job < 528) { const int j = job - 352; m = 1; tr = j / 11; tk = j % 11; K = 2816; dst = (bf16_t*)(W + W_D1); }
        else if (job < 1056) { const int j = job - 528; m = 2; tr = j >> 2; tk = j & 3; K = 1024; dst = (bf16_t*)(W + W_IN); }
        else if (job < 1248) { const int j = job - 1056; m = 3 + (j >> 6); tr = (j & 63) >> 2; tk = j & 3; K = 1024; dst = (bf16_t*)(W + W_GO + (size_t)(m - 3) * 2097152); }
        else if (job < 1600) { const int j = job - 1248; m = 6; tr = j >> 2; tk = j & 3; K = 1024; dst = (bf16_t*)(W + W_GU2); }
        else { const int j = job - 1600; m = 7; tr = j / 11; tk = j % 11; K = 2816; dst = (bf16_t*)(W + W_D2); }
        const int r0 = tr * 64, k0 = tk * 256, nn = tid & 63, kk = tid >> 6, row = r0 + nn;
        const float* src; size_t ld; int sc;
        switch (m) {
            case 0: src = (((row >> 7) & 1) ? p.in[8] : p.in[7]) + (size_t)layer * 1024 * DFF; ld = DFF; sc = (row >> 8) * 128 + (row & 127); break;
            case 1: src = p.in[9] + (size_t)layer * DFF * 1024; ld = 1024; sc = row; break;
            case 2: src = p.in[11] + (size_t)layer * 1024 * INW; ld = INW; sc = win_src(row); break;
            case 3: src = p.in[17] + (size_t)layer * 1024 * 1024; ld = 1024; sc = row; break;
            case 4: src = p.in[28] + (size_t)layer * 1024 * 1024; ld = 1024; sc = row; break;
            case 5: src = p.in[29] + (size_t)layer * 1024 * 1024; ld = 1024; sc = row; break;
            case 6: src = (((row >> 7) & 1) ? p.in[32] : p.in[31]) + (size_t)layer * 1024 * DFF; ld = DFF; sc = (row >> 8) * 128 + (row & 127); break;
            default: src = p.in[33] + (size_t)layer * DFF * 1024; ld = 1024; sc = row; break;
        }
        { const float* sp = src + (size_t)(k0 + kk) * ld + (sc >= 0 ? sc : 0); float v[32];
#pragma unroll
          for (int i = 0; i < 32; ++i) v[i] = sp[(size_t)(8 * i) * ld];
#pragma unroll
          for (int i = 0; i < 32; ++i) tile[(kk + 8 * i) * 65 + nn] = sc >= 0 ? v[i] : 0.f; }
        __syncthreads();
        { const int n2 = tid >> 3, kq = tid & 7;
#pragma unroll
          for (int kb = 0; kb < 4; ++kb) { float v[8];
#pragma unroll
              for (int i = 0; i < 8; ++i) v[i] = tile[(kb * 64 + kq * 8 + i) * 65 + n2];
              *(u32x4*)(dst + (size_t)(r0 + n2) * K + k0 + kb * 64 + kq * 8) = pack8(v); } }
        __syncthreads();
    }
}

DEVI void gla_prep_phase(const Params& p, int layer, int vc, bf16_t* Pg, bf16_t* QF, bf16_t* KF, float* DEC, bf16_t* ATTf, bf16_t* ATTb, unsigned char* smem) {
    const int tid = otid(), lane = tid & 63, wid = tid >> 6, lr = lane & 15, lq = lane >> 4;
    float* sB = (float*)smem;
    const int r = tid >> 3, seg = tid & 7, d0 = wid * 16;
    const int njobs = vc >= 0 ? 136 : 1088, jstart = vc >= 0 ? (vc >> 3) : (int)blockIdx.x, jstep = vc >= 0 ? 32 : (int)gridDim.x;
    for (int job = jstart; job < njobs; job += jstep) {
        int cgi, h;
        if (vc >= 0) { const int xb_ = (vc & 7) >> 1, ci = job >> 1; h = 2 * (vc & 1) + (job & 1); cgi = ci < 64 ? xb_ * 64 + ci : 256 + xb_ * 4 + (ci - 64); }
        else { cgi = job >> 2; h = job & 3; }
        const int base = cgi * 64;
        const bf16_t* rowp = Pg + (size_t)(base + r) * PGW;
        const u32x4 q0 = *(const u32x4*)(rowp + 1536 + h * 128 + seg * 8), q1 = *(const u32x4*)(rowp + 1536 + h * 128 + 64 + seg * 8);
        const u32x4 k0 = *(const u32x4*)(rowp + h * 128 + seg * 8), k1 = *(const u32x4*)(rowp + h * 128 + 64 + seg * 8);
#pragma unroll
        for (int dir = 0; dir < 2; ++dir) {
            const float* wa = (dir ? p.in[14] : p.in[12]) + layer * 16 * 512; const float* ba = (dir ? p.in[15] : p.in[13]) + layer * 512;
            bf16x8 bwa; { float t[8];
#pragma unroll
                for (int i = 0; i < 8; ++i) t[i] = wa[((lq & 1) * 8 + i) * 512 + h * 128 + d0 + lr];
#pragma unroll
                for (int i = 0; i < 8; ++i) t[i] = lq < 2 ? t[i] : 0.f;
                bwa = __builtin_bit_cast(bf16x8, pack8(t)); }
            const float ba_d = ba[h * 128 + d0 + lr];
            const int acol = 3072 + dir * 16;
            float off = 0.f; float bv[4][4];
#pragma unroll
            for (int rt = 0; rt < 4; ++rt) { const int rr = rt * 16 + lr; const u32x4 fa = *(const u32x4*)(Pg + (size_t)(base + (dir ? 63 - rr : rr)) * PGW + acol + (lq & 1) * 8);
                const bf16x8 af = lq < 2 ? __builtin_bit_cast(bf16x8, fa) : (bf16x8){0, 0, 0, 0, 0, 0, 0, 0};
                const f32x4 x = __builtin_amdgcn_mfma_f32_16x16x32_bf16(af, bwa, (f32x4){0.f, 0.f, 0.f, 0.f}, 0, 0, 0);
                float run = 0.f;
#pragma unroll
                for (int g = 0; g < 4; ++g) { const float xv = x[g] + ba_d; run += (fminf(xv, 0.f) - __logf(1.f + __expf(-fabsf(xv)))) * 0.0625f; bv[rt][g] = run; }
                float inc = run;
                float u = __int_as_float(__builtin_amdgcn_ds_bpermute((lane - 16) << 2, __float_as_int(inc))); if (lq >= 1) inc += u;
                u = __int_as_float(__builtin_amdgcn_ds_bpermute((lane - 32) << 2, __float_as_int(inc))); if (lq >= 2) inc += u;
                const float tot = __int_as_float(__builtin_amdgcn_ds_bpermute((48 + lr) << 2, __float_as_int(inc)));
                const float bs = off + (inc - run); off += tot;
#pragma unroll
                for (int g = 0; g < 4; ++g) sB[(dir * 64 + rt * 16 + lq * 4 + g) * 132 + d0 + lr] = bs + bv[rt][g]; }
            if (lq == 0) DEC[((size_t)dir * 272 + cgi) * 512 + h * 128 + d0 + lr] = __expf(off);
        }
        __syncthreads();
        { float qf[16], kf[16]; unpack8(q0, qf); unpack8(q1, qf + 8); unpack8(k0, kf); unpack8(k1, kf + 8);
          const size_t tok = (size_t)(base + r);
#pragma unroll
          for (int dir = 0; dir < 2; ++dir) {
              bf16_t* qdst = dir ? Pg + tok * PGW + 1536 + h * 128 : QF + tok * 512 + h * 128;
              bf16_t* kdst = dir ? Pg + tok * PGW + h * 128 : KF + tok * 512 + h * 128;
              const float* sb = sB + (dir * 64 + (dir ? 63 - r : r)) * 132;
#pragma unroll
              for (int hh = 0; hh < 2; ++hh) { const int db = hh * 64 + seg * 8; float qd[8], kn[8];
                  const f32x4 b0 = *(const f32x4*)(sb + db), b1 = *(const f32x4*)(sb + db + 4);
#pragma unroll
                  for (int e = 0; e < 8; ++e) { const float bb = e < 4 ? b0[e & 3] : b1[e & 3]; const float eb = __expf(bb), enb = __builtin_amdgcn_rcpf(eb);
                      qd[e] = qf[hh * 8 + e] * 0.08838834764831845f * eb; kn[e] = kf[hh * 8 + e] * enb; }
                  const u32x4 qw = pack8(qd), kw = pack8(kn);
                  *(u32x4*)(qdst + db) = qw; *(u32x4*)(kdst + db) = kw;
                  bf16_t* tq_ = (bf16_t*)(smem + 67584 + dir * 34816) + (dir ? 63 - r : r) * 136 + db;
                  *(u32x4*)tq_ = qw; *(u32x4*)(tq_ + 8704) = kw; } } }
        __syncthreads();
        { const int dir = wid >> 2, ib = wid & 3, i0 = ib * 16;
          const bf16_t* Qd = (const bf16_t*)(smem + 67584 + dir * 34816); const bf16_t* Kd = Qd + 8704;
          bf16_t* dst = (dir ? ATTb : ATTf) + ((size_t)(cgi * 4 + h)) * 4096 + (i0 + lr) * 64 + lq * 4;
          bf16x8 qfr[4];
#pragma unroll
          for (int ks = 0; ks < 4; ++ks) qfr[ks] = *(const bf16x8*)(Qd + (i0 + lr) * 136 + ks * 32 + lq * 8);
#pragma unroll
          for (int jb = 0; jb < 4; ++jb) { f32x4 a = (f32x4){0.f, 0.f, 0.f, 0.f};
              if (jb <= ib) {
#pragma unroll
                  for (int ks = 0; ks < 4; ++ks) { const bf16x8 kfr = *(const bf16x8*)(Kd + (jb * 16 + lr) * 136 + ks * 32 + lq * 8); a = __builtin_amdgcn_mfma_f32_16x16x32_bf16(kfr, qfr[ks], a, 0, 0, 0); } }
              const int i = i0 + lr, j0 = jb * 16 + lq * 4;
              u32x2 w; w.x = cvt_pk_bf16(j0 <= i ? a[0] : 0.f, j0 + 1 <= i ? a[1] : 0.f); w.y = cvt_pk_bf16(j0 + 2 <= i ? a[2] : 0.f, j0 + 3 <= i ? a[3] : 0.f);
              *(u32x2*)(dst + jb * 16) = w; } }
        __syncthreads();
    }
}

DEVI bf16x8 tr_frag(unsigned a0, unsigned a1) {
    u32x2 lo, hi;
    asm volatile("ds_read_b64_tr_b16 %0, %2\n\tds_read_b64_tr_b16 %1, %3\n\ts_waitcnt lgkmcnt(0)" : "=&v"(lo), "=&v"(hi) : "v"(a0), "v"(a1) : "memory");
    return __builtin_bit_cast(bf16x8, (u32x4){lo.x, lo.y, hi.x, hi.y});
}
DEVI void tr_frag2(unsigned a0, unsigned d0, unsigned a1, unsigned d1, bf16x8& f0, bf16x8& f1) {
    u32x2 l0, h0, l1, h1;
    asm volatile("ds_read_b64_tr_b16 %0, %4\n\tds_read_b64_tr_b16 %1, %5\n\tds_read_b64_tr_b16 %2, %6\n\tds_read_b64_tr_b16 %3, %7\n\ts_waitcnt lgkmcnt(0)"
                 : "=&v"(l0), "=&v"(h0), "=&v"(l1), "=&v"(h1) : "v"(a0), "v"(a0 + d0), "v"(a1), "v"(a1 + d1) : "memory");
    f0 = __builtin_bit_cast(bf16x8, (u32x4){l0.x, l0.y, h0.x, h0.y}); f1 = __builtin_bit_cast(bf16x8, (u32x4){l1.x, l1.y, h1.x, h1.y});
}
DEVI void tr_frag4(unsigned a0, unsigned a1, unsigned da, unsigned b0, unsigned b1, unsigned db, bf16x8& fa0, bf16x8& fa1, bf16x8& fb0, bf16x8& fb1) {
    u32x2 l0, h0, l1, h1, l2, h2, l3, h3;
    asm volatile("ds_read_b64_tr_b16 %0, %8\n\tds_read_b64_tr_b16 %1, %9\n\tds_read_b64_tr_b16 %2, %10\n\tds_read_b64_tr_b16 %3, %11\n\t"
                 "ds_read_b64_tr_b16 %4, %12\n\tds_read_b64_tr_b16 %5, %13\n\tds_read_b64_tr_b16 %6, %14\n\tds_read_b64_tr_b16 %7, %15\n\ts_waitcnt lgkmcnt(0)"
                 : "=&v"(l0), "=&v"(h0), "=&v"(l1), "=&v"(h1), "=&v"(l2), "=&v"(h2), "=&v"(l3), "=&v"(h3)
                 : "v"(a0), "v"(a0 + da), "v"(a1), "v"(a1 + da), "v"(b0), "v"(b0 + db), "v"(b1), "v"(b1 + db) : "memory");
    fa0 = __builtin_bit_cast(bf16x8, (u32x4){l0.x, l0.y, h0.x, h0.y}); fa1 = __builtin_bit_cast(bf16x8, (u32x4){l1.x, l1.y, h1.x, h1.y});
    fb0 = __builtin_bit_cast(bf16x8, (u32x4){l2.x, l2.y, h2.x, h2.y}); fb1 = __builtin_bit_cast(bf16x8, (u32x4){l3.x, l3.y, h3.x, h3.y});
}
DEVI void tr_frag3(unsigned a0, unsigned a1, unsigned da, unsigned b0, unsigned db, bf16x8& f0, bf16x8& f1, bf16x8& f2) {
    u32x2 l0, h0, l1, h1, l2, h2;
    asm volatile("ds_read_b64_tr_b16 %0, %6\n\tds_read_b64_tr_b16 %1, %7\n\tds_read_b64_tr_b16 %2, %8\n\tds_read_b64_tr_b16 %3, %9\n\t"
                 "ds_read_b64_tr_b16 %4, %10\n\tds_read_b64_tr_b16 %5, %11\n\ts_waitcnt lgkmcnt(0)"
                 : "=&v"(l0), "=&v"(h0), "=&v"(l1), "=&v"(h1), "=&v"(l2), "=&v"(h2)
                 : "v"(a0), "v"(a0 + da), "v"(a1), "v"(a1 + da), "v"(b0), "v"(b0 + db) : "memory");
    f0 = __builtin_bit_cast(bf16x8, (u32x4){l0.x, l0.y, h0.x, h0.y}); f1 = __builtin_bit_cast(bf16x8, (u32x4){l1.x, l1.y, h1.x, h1.y}); f2 = __builtin_bit_cast(bf16x8, (u32x4){l2.x, l2.y, h2.x, h2.y});
}
DEVI void gla_phase(const Params& p, int layer, int vc, const bf16_t* Pg, const bf16_t* QF, const bf16_t* KF, const float* DEC, const bf16_t* ATTf, const bf16_t* ATTb, bf16_t* Of, bf16_t* Ob, unsigned char* smem) {
    const int tid = otid(), lane = tid & 63, wid = tid >> 6, lr = lane & 15, lq = lane >> 4;
    constexpr int BUF = 49664;
    bf16_t* sST = (bf16_t*)(smem + 2 * BUF);
    const unsigned lds0 = (unsigned)(size_t)smem;
    const int r = tid >> 3, seg = tid & 7, r2 = (tid >> 2) & 63, sg = tid & 3;
    const int tq = (lane & 15) >> 2, tp = lane & 3;
    const int jstart = vc >= 0 ? (((vc & 7) * 4 + (vc >> 6)) * 8 + ((vc >> 3) & 7)) : (int)blockIdx.x, jstep = vc >= 0 ? 256 : (int)gridDim.x;
    for (int job = jstart; job < 256; job += jstep) {
        const int sl = job & 7, grp = job >> 3, dir = grp & 1, h = (grp >> 1) & 3, b = grp >> 3;
        for (int i = tid; i < 2 * 32 * 136 / 2; i += 512) ((unsigned*)sST)[i] = 0u;
        f32x4 S[2];
        S[0] = (f32x4){0.f, 0.f, 0.f, 0.f}; S[1] = (f32x4){0.f, 0.f, 0.f, 0.f};
        bf16_t* O = dir ? Ob : Of; const bf16_t* ATTd = dir ? ATTb : ATTf;
        const int vcol = 512 + h * 256 + sl * 32 + sg * 8;
        u32x4 qa0, qa1, ka0, ka1, va, ata, qb0, qb1, kb0, kb1, vb, atb; f32x4 dca, dcb;
#define GLA_BASE(s_) ((s_) < 4 ? MLAT + b * 256 + (dir ? 3 - (s_) : (s_)) * 64 : b * 4096 + (dir ? 63 - ((s_) - 4) : ((s_) - 4)) * 64)
#define GLA_LOAD(s_, q0, q1, k0, k1, vr, at, dc) do { const int base_ = GLA_BASE(s_); const size_t tok_ = (size_t)(base_ + (dir ? 63 - r : r)); \
            const bf16_t* qp_ = dir ? Pg + tok_ * PGW + 1536 + h * 128 + seg * 8 : QF + tok_ * 512 + h * 128 + seg * 8; \
            const bf16_t* kp_ = dir ? Pg + tok_ * PGW + h * 128 + seg * 8 : KF + tok_ * 512 + h * 128 + seg * 8; \
            q0 = *(const u32x4*)qp_; q1 = *(const u32x4*)(qp_ + 64); k0 = *(const u32x4*)kp_; k1 = *(const u32x4*)(kp_ + 64); \
            vr = *(const u32x4*)(Pg + (size_t)(base_ + (dir ? 63 - r2 : r2)) * PGW + vcol); \
            at = *(const u32x4*)(ATTd + ((size_t)((base_ >> 6) * 4 + h)) * 4096 + tid * 8); \
            dc = *(const f32x4*)(DEC + ((size_t)dir * 272 + (base_ >> 6)) * 512 + h * 128 + (tid & 31) * 4); } while (0)
#define GLA_FILL(bf_, q0, q1, k0, k1, vr, at, dc) do { unsigned char* bb_ = smem + (bf_) * BUF; bf16_t* sQ_ = (bf16_t*)bb_; bf16_t* sK_ = (bf16_t*)(bb_ + 17408); bf16_t* sV_ = (bf16_t*)(bb_ + 34816); \
            *(u32x4*)(sQ_ + r * 136 + seg * 8) = q0; *(u32x4*)(sQ_ + r * 136 + 64 + seg * 8) = q1; *(u32x4*)(sK_ + r * 136 + seg * 8) = k0; *(u32x4*)(sK_ + r * 136 + 64 + seg * 8) = k1; \
            *(u32x4*)((bf16_t*)(bb_ + 40448) + r * 72 + seg * 8) = at; \
            if (tid < 256) *(u32x4*)(sV_ + r2 * 40 + sg * 8) = vr; if (tid < 32) *(f32x4*)(bb_ + 39936 + tid * 16) = dc; } while (0)
        GLA_LOAD(0, qa0, qa1, ka0, ka1, va, ata, dca); GLA_LOAD(1, qb0, qb1, kb0, kb1, vb, atb, dcb);
        GLA_FILL(0, qa0, qa1, ka0, ka1, va, ata, dca);
        GLA_LOAD(2, qa0, qa1, ka0, ka1, va, ata, dca);
        __syncthreads();
        auto step = [&](const int s, u32x4& q0, u32x4& q1, u32x4& k0, u32x4& k1, u32x4& vr, u32x4& at, f32x4& dcn) __attribute__((always_inline)) {
            const int base = GLA_BASE(s);
            const int cur = s & 1, nx = cur ^ 1;
            const bf16_t* sQ = (const bf16_t*)(smem + cur * BUF); const bf16_t* sAtt = (const bf16_t*)(smem + cur * BUF + 40448);
            const unsigned aK = lds0 + cur * BUF + 17408, aV = lds0 + cur * BUF + 34816;
            { bf16x8 v0[2], v1[2], kt[2];
#pragma unroll
              for (int ks = 0; ks < 2; ++ks) { const int row0 = ks * 32 + lq * 8 + tq; const unsigned av = aV + row0 * 80 + tp * 8, ak = aK + row0 * 272 + (wid * 16 + tp * 4) * 2;
                  tr_frag3(av, av + 32, 4 * 80, ak, 4 * 272, v0[ks], v1[ks], kt[ks]); }
#pragma unroll
              for (int ks = 0; ks < 2; ++ks) { S[0] = __builtin_amdgcn_mfma_f32_16x16x32_bf16(kt[ks], v0[ks], S[0], 0, 0, 0); S[1] = __builtin_amdgcn_mfma_f32_16x16x32_bf16(kt[ks], v1[ks], S[1], 0, 0, 0); }
              const f32x4 dec = *(const f32x4*)(smem + cur * BUF + 39936 + (wid * 16 + lq * 4) * 4);
#pragma unroll
              for (int cb = 0; cb < 2; ++cb) { S[cb] *= dec; u32x2 w; w.x = cvt_pk_bf16(S[cb][0], S[cb][1]); w.y = cvt_pk_bf16(S[cb][2], S[cb][3]);
                  *(u32x2*)(sST + nx * 4352 + (cb * 16 + lr) * 136 + wid * 16 + lq * 4) = w; } }
            { const int i0 = (wid & 3) * 16, dvb = wid >> 2; f32x4 a = (f32x4){0.f, 0.f, 0.f, 0.f}, a2 = (f32x4){0.f, 0.f, 0.f, 0.f};
              bf16x8 sf[4], qf[4], af[2], vt[2];
#pragma unroll
              for (int ks = 0; ks < 4; ++ks) { sf[ks] = *(const bf16x8*)(sST + cur * 4352 + (dvb * 16 + lr) * 136 + ks * 32 + lq * 8); qf[ks] = *(const bf16x8*)(sQ + (i0 + lr) * 136 + ks * 32 + lq * 8); }
#pragma unroll
              for (int ks = 0; ks < 2; ++ks) af[ks] = *(const bf16x8*)(sAtt + (i0 + lr) * 72 + ks * 32 + lq * 8);
              { const unsigned av = aV + (lq * 8 + tq) * 80 + (dvb * 16 + tp * 4) * 2; tr_frag2(av, 4 * 80, av + 32 * 80, 4 * 80, vt[0], vt[1]); }
              a = __builtin_amdgcn_mfma_f32_16x16x32_bf16(sf[0], qf[0], a, 0, 0, 0); a2 = __builtin_amdgcn_mfma_f32_16x16x32_bf16(vt[0], af[0], a2, 0, 0, 0);
              a = __builtin_amdgcn_mfma_f32_16x16x32_bf16(sf[1], qf[1], a, 0, 0, 0); a2 = __builtin_amdgcn_mfma_f32_16x16x32_bf16(vt[1], af[1], a2, 0, 0, 0);
              a = __builtin_amdgcn_mfma_f32_16x16x32_bf16(sf[2], qf[2], a, 0, 0, 0); a2 = __builtin_amdgcn_mfma_f32_16x16x32_bf16(sf[3], qf[3], a2, 0, 0, 0);
              a += a2;
              const int i = i0 + lr; u32x2 w; w.x = cvt_pk_bf16(a[0], a[1]); w.y = cvt_pk_bf16(a[2], a[3]);
              *(u32x2*)(O + (size_t)(base + (dir ? 63 - i : i)) * DM + h * 256 + sl * 32 + dvb * 16 + lq * 4) = w; }
            GLA_FILL(nx, q0, q1, k0, k1, vr, at, dcn); { const int s3 = s + 3 < 68 ? s + 3 : 67; GLA_LOAD(s3, q0, q1, k0, k1, vr, at, dcn); }
            __syncthreads();
        };
#pragma unroll 1
        for (int s = 0; s < 68; s += 2) { step(s, qb0, qb1, kb0, kb1, vb, atb, dcb); step(s + 1, qa0, qa1, ka0, ka1, va, ata, dca); }
#undef GLA_BASE
#undef GLA_LOAD
#undef GLA_FILL
    }
}

DEVI void gla_post_phase(const Params& p, int layer, const bf16_t* Pg, bf16_t* Of, const bf16_t* Ob, int M) {
    const int tid_ = otid(), lane = tid_ & 63, wid = tid_ >> 6;
    float gn[16]; { const f32x4* gp = (const f32x4*)(p.in[16] + layer * 1024 + lane * 16);
#pragma unroll
      for (int i = 0; i < 4; ++i) { const f32x4 t = gp[i]; gn[i * 4] = t[0]; gn[i * 4 + 1] = t[1]; gn[i * 4 + 2] = t[2]; gn[i * 4 + 3] = t[3]; } }
    for (int row = blockIdx.x * 8 + wid; row < M; row += gridDim.x * 8) {
        float of[16], ob[16], rr[16];
        bf16_t* op = Of + (size_t)row * DM + lane * 16; const bf16_t* bp = Ob + (size_t)row * DM + lane * 16; const bf16_t* rp = Pg + (size_t)row * PGW + 2048 + lane * 16;
        unpack8(*(const u32x4*)op, of); unpack8(*(const u32x4*)(op + 8), of + 8); unpack8(*(const u32x4*)bp, ob); unpack8(*(const u32x4*)(bp + 8), ob + 8);
        unpack8(*(const u32x4*)rp, rr); unpack8(*(const u32x4*)(rp + 8), rr + 8);
        float ss = 0.f;
#pragma unroll
        for (int i = 0; i < 16; ++i) { of[i] += ob[i]; ss += of[i] * of[i]; }
        ss += shx(ss, lane, 1); ss += shx(ss, lane, 2); ss += shx(ss, lane, 4); ss += shx(ss, lane, 8);
        const float rstd = rsqrtf(ss * (1.f / 256.f) + 1e-6f);
#pragma unroll
        for (int i = 0; i < 16; ++i) of[i] = of[i] * rstd * gn[i] * silu_f(rr[i]);
        *(u32x4*)op = pack8(of); *(u32x4*)(op + 8) = pack8(of + 8);
    }
}

DEVI void transpose_phase(const bf16_t* Z, bf16_t* Ah, int M, unsigned char* shm) {
    bf16_t* tile = (bf16_t*)shm;
    const int tid = otid(), ntt = M / 64, njobs = 16 * ntt;
    const int cr = tid >> 3, sg = tid & 7;
    int job = blockIdx.x;
    u32x4 cur = (u32x4){0u, 0u, 0u, 0u};
    if (job < njobs) cur = *(const u32x4*)(Z + (size_t)((job % 16) * 64 + cr) * MTOT + (job / 16) * 64 + sg * 8);
    int par = 0;
    for (; job < njobs; job += gridDim.x) {
        const int c0 = (job % 16) * 64, t0 = (job / 16) * 64;
        const int nj = job + (int)gridDim.x < njobs ? job + (int)gridDim.x : job;
        const u32x4 nxt = *(const u32x4*)(Z + (size_t)((nj % 16) * 64 + cr) * MTOT + (nj / 16) * 64 + sg * 8);
        bf16_t* tl = tile + par * (64 * 72);
        *(u32x4*)(tl + cr * 72 + sg * 8) = cur;
        __syncthreads();
        { const int tr = cr; unsigned w[4];
#pragma unroll
          for (int e = 0; e < 4; ++e) w[e] = (unsigned)tl[(sg * 8 + 2 * e) * 72 + tr] | ((unsigned)tl[(sg * 8 + 2 * e + 1) * 72 + tr] << 16);
          *(u32x4*)(Ah + (size_t)(t0 + tr) * DM + c0 + sg * 8) = (u32x4){w[0], w[1], w[2], w[3]}; }
        cur = nxt; par ^= 1;
    }
    __syncthreads();
}

DEVI float hy_delta(int c) { const float mn = -3.0701134573253940f, mx = -15.350567286626970f; return fabsf(mn + (mx - mn) * ((float)c * (1.f / 1023.f))); }

DEVI void taps_phase(const Params& p, int layer, const float* H2l, bf16_t* TAPS, float* INVN, unsigned char* shm) {
    float* w3s = (float*)shm;
    float* red = (float*)(shm + 4096);
    const int tid = otid(), lane = tid & 63, wid = tid >> 6, lr = lane & 15, lq = lane >> 4;
    const float* w3 = p.in[26] + (size_t)layer * 64 * 4096;
    for (int job = blockIdx.x; job < 256; job += gridDim.x) {
        const int o = job >> 7, c0 = (job & 127) * 8;
        for (int i = tid; i < 1024; i += 512) { const int j = i >> 4, q = i & 15; w3s[i] = w3[j * 4096 + (q >> 3) * 2048 + o * 1024 + c0 + (q & 7)]; }
        __syncthreads();
        bf16x8 bw[2];
#pragma unroll
        for (int ks = 0; ks < 2; ++ks) { float t[8];
#pragma unroll
            for (int i = 0; i < 8; ++i) t[i] = w3s[(ks * 32 + lq * 8 + i) * 16 + lr];
            bw[ks] = __builtin_bit_cast(bf16x8, pack8(t)); }
        const float delta = hy_delta(c0 + (lr & 7));
        bf16_t* dst = TAPS + ((size_t)((o * 2 + (lr >> 3)) * 1024 + c0 + (lr & 7))) * 4096;
        float part = 0.f;
#pragma unroll 2
        for (int tile = 0; tile < 32; ++tile) {
            const int tb = wid * 512 + tile * 16;
            const float* hr = H2l + (size_t)(tb + lr) * 64 + lq * 8;
            f32x4 acc = (f32x4){0.f, 0.f, 0.f, 0.f};
#pragma unroll
            for (int ks = 0; ks < 2; ++ks) { const f32x4 h0 = *(const f32x4*)(hr + ks * 32), h1 = *(const f32x4*)(hr + ks * 32 + 4);
                const float t[8] = {h0[0], h0[1], h0[2], h0[3], h1[0], h1[1], h1[2], h1[3]};
                acc = __builtin_amdgcn_mfma_f32_16x16x32_bf16(__builtin_bit_cast(bf16x8, pack8(t)), bw[ks], acc, 0, 0, 0); }
            const int t0 = tb + lq * 4;
            float v[4];
#pragma unroll
            for (int g = 0; g < 4; ++g) { v[g] = acc[g] * __expf(-((float)(t0 + g) * (1.f / 4095.f)) * delta); part += (lr >= 8 && t0 + g == 0) ? 0.f : fabsf(v[g]); }
            u32x2 w; w.x = cvt_pk_bf16(v[0], v[1]); w.y = cvt_pk_bf16(v[2], v[3]);
            *(u32x2*)(dst + t0) = w;
        }
        part += shx(part, lane, 16); part += shx(part, lane, 32);
        if (lq == 0) red[wid * 16 + lr] = part;
        __syncthreads();
        if (tid < 8) { float t = 0.f; for (int w = 0; w < 8; ++w) t += red[w * 16 + tid] + red[w * 16 + 8 + tid]; INVN[o * 1024 + c0 + tid] = 1.f / (t + 1e-6f); }
        __syncthreads();
    }
}

DEVI void taps_own(const Params& p, int layer, const float* H2l, bf16_t* TAPS, float* INVN, unsigned char* shm) {
    float* w3s = (float*)shm;
    float* red = (float*)(shm + 4096);
    const int tid = otid(), lane = tid & 63, wid = tid >> 6, lr = lane & 15, lq = lane >> 4;
    const float* w3 = p.in[26] + (size_t)layer * 64 * 4096;
    const int G = (int)gridDim.x;
    for (int cb = (int)blockIdx.x; cb < 1024; cb += 4 * G) {
        for (int i = tid; i < 1024; i += 512) { const int j = i >> 4, q = i & 15; int c = cb + (q & 3) * G; c = c < 1024 ? c : cb;
            w3s[i] = w3[j * 4096 + (q >> 3) * 2048 + ((q >> 2) & 1) * 1024 + c]; }
        __syncthreads();
        bf16x8 bw[2];
#pragma unroll
        for (int ks = 0; ks < 2; ++ks) { float t[8];
#pragma unroll
            for (int i = 0; i < 8; ++i) t[i] = w3s[(ks * 32 + lq * 8 + i) * 16 + lr];
            bw[ks] = __builtin_bit_cast(bf16x8, pack8(t)); }
        const int cmine = cb + (lr & 3) * G; const bool cok = cmine < 1024; const int cc = cok ? cmine : cb;
        const int om = (lr >> 2) & 1, dm = lr >> 3;
        const float delta = hy_delta(cc);
        bf16_t* dst = TAPS + ((size_t)((om * 2 + dm) * 1024 + cc)) * 4096;
        float part = 0.f;
#pragma unroll 2
        for (int tile = 0; tile < 32; ++tile) {
            const int tb = wid * 512 + tile * 16;
            const float* hr = H2l + (size_t)(tb + lr) * 64 + lq * 8;
            f32x4 acc = (f32x4){0.f, 0.f, 0.f, 0.f};
#pragma unroll
            for (int ks = 0; ks < 2; ++ks) { const f32x4 h0 = *(const f32x4*)(hr + ks * 32), h1 = *(const f32x4*)(hr + ks * 32 + 4);
                const float t[8] = {h0[0], h0[1], h0[2], h0[3], h1[0], h1[1], h1[2], h1[3]};
                acc = __builtin_amdgcn_mfma_f32_16x16x32_bf16(__builtin_bit_cast(bf16x8, pack8(t)), bw[ks], acc, 0, 0, 0); }
            const int t0 = tb + lq * 4;
            float v[4];
#pragma unroll
            for (int g = 0; g < 4; ++g) { v[g] = acc[g] * __expf(-((float)(t0 + g) * (1.f / 4095.f)) * delta); part += (dm == 1 && t0 + g == 0) ? 0.f : fabsf(v[g]); }
            u32x2 w; w.x = cvt_pk_bf16(v[0], v[1]); w.y = cvt_pk_bf16(v[2], v[3]);
            if (cok) *(u32x2*)(dst + t0) = w;
        }
        part += shx(part, lane, 16); part += shx(part, lane, 32);
        if (lq == 0) red[wid * 16 + lr] = part;
        __syncthreads();
        if (tid < 8) { float t = 0.f; for (int w = 0; w < 8; ++w) t += red[w * 16 + tid] + red[w * 16 + 8 + tid];
            const int c = cb + (tid & 3) * G; if (c < 1024) INVN[(tid >> 2) * 1024 + c] = 1.f / (t + 1e-6f); }
        __syncthreads();
    }
}

DEVI int padi(int i) { return i + ((i >> 5) << 1); }
DEVI f32x2 cmul(f32x2 a, f32x2 b) { return (f32x2){a.x * b.x - a.y * b.y, a.x * b.y + a.y * b.x}; }
DEVI f32x2 cmulc(f32x2 a, f32x2 b) { return (f32x2){a.x * b.x + a.y * b.y, a.y * b.x - a.x * b.y}; }
DEVI f32x2 twid(int m, float invN) {
    const float fr = (float)m * invN, qf = rintf(fr * 4.f), r = fr - qf * 0.25f, ph = r * 6.283185307179586f, p2 = ph * ph;
    const float s = ph * (1.f + p2 * (-1.f / 6.f + p2 * (1.f / 120.f + p2 * (-1.f / 5040.f + p2 * (1.f / 362880.f)))));
    const float c = 1.f + p2 * (-0.5f + p2 * (1.f / 24.f + p2 * (-1.f / 720.f + p2 * (1.f / 40320.f + p2 * (-1.f / 3628800.f)))));
    const int q = ((int)qf) & 3;
    const float cs = (q == 0) ? c : (q == 1) ? -s : (q == 2) ? -c : s;
    const float sn = (q == 0) ? s : (q == 1) ? c : (q == 2) ? -s : -c;
    return (f32x2){cs, -sn};
}
#define W16C(m) ((m) == 0 ? 1.f : (m) == 1 ? 0.9238795325112867f : (m) == 2 ? 0.7071067811865476f : (m) == 3 ? 0.3826834323650898f : (m) == 4 ? 0.f : (m) == 5 ? -0.3826834323650898f : (m) == 6 ? -0.7071067811865476f : -0.9238795325112867f)
#define W16S(m) ((m) == 0 ? 0.f : (m) == 1 ? -0.3826834323650898f : (m) == 2 ? -0.7071067811865476f : (m) == 3 ? -0.9238795325112867f : (m) == 4 ? -1.f : (m) == 5 ? -0.9238795325112867f : (m) == 6 ? -0.7071067811865476f : -0.3826834323650898f)

DEVI f32x2 rot16(f32x2 t, int m) { return m == 0 ? t : (m == 4 ? (f32x2){t.y, -t.x} : cmul(t, (f32x2){W16C(m), W16S(m)})); }
template <bool INV> DEVI void bfly16(f32x2 (&x)[16], f32x2 t1) {
    f32x2 tq[4]; tq[0] = t1; tq[1] = cmul(tq[0], tq[0]); tq[2] = cmul(tq[1], tq[1]); tq[3] = cmul(tq[2], tq[2]);
    if (!INV) {
#pragma unroll
        for (int q = 0; q < 4; ++q) { const int half = 8 >> q;
#pragma unroll
            for (int blk = 0; blk < (1 << q); ++blk)
#pragma unroll
                for (int jj = 0; jj < half; ++jj) { const int i0 = blk * 2 * half + jj, i1 = i0 + half; const int m = (jj << q) & 15;
                    const f32x2 T = rot16(tq[q], m);
                    const f32x2 a = x[i0], b = x[i1]; x[i0] = a + b; x[i1] = cmul(a - b, T); } }
    } else {
#pragma unroll
        for (int q = 3; q >= 0; --q) { const int half = 8 >> q;
#pragma unroll
            for (int blk = 0; blk < (1 << q); ++blk)
#pragma unroll
                for (int jj = 0; jj < half; ++jj) { const int i0 = blk * 2 * half + jj, i1 = i0 + half; const int m = (jj << q) & 15;
                    const f32x2 T = rot16(tq[q], m);
                    const f32x2 a = x[i0], b = cmulc(x[i1], T); x[i0] = a + b; x[i1] = a - b; } }
    }
}
template <int S0, bool INV, bool EDGE = false> DEVI void fft_pass(f32x2* buf, int tid_, f32x2 t1_) {
    int tid = tid_; asm volatile("" : "+v"(tid));
    float t1x = t1_.x, t1y = t1_.y; asm volatile("" : "+v"(t1x), "+v"(t1y));
    const f32x2 t1 = (f32x2){t1x, t1y};
    constexpr int stride = 8192 >> (S0 + 4);
    constexpr int cs = S0 == 0 ? 544 : (S0 == 4 ? 34 : 2);
    const int lo = tid & (stride - 1), hi = tid / stride;
    const int pbase = S0 == 0 ? padi(tid) : (S0 == 4 ? hi * 544 + lo : hi * 34 + lo);
    f32x2* pb = buf + pbase;
    f32x2 x[16];
#pragma unroll
    for (int j = 0; j < 16; ++j) x[j] = (EDGE && !INV && j >= 8) ? (f32x2){0.f, 0.f} : pb[j * cs];
    bfly16<INV>(x, t1);
#pragma unroll
    for (int j = 0; j < 16; ++j) if (!(EDGE && INV && j >= 8)) pb[j * cs] = x[j];
}
DEVI float dpp_swap1(float v) { return __int_as_float(__builtin_amdgcn_mov_dpp(__float_as_int(v), 0xB1, 0xF, 0xF, true)); }
template <int MODE> DEVI void fft_mid3(f32x2* buf, const f32x2* hbuf, int tid_, f32x2 t1_) {
    int tid = tid_; asm volatile("" : "+v"(tid));
    float t1x = t1_.x, t1y = t1_.y; asm volatile("" : "+v"(t1x), "+v"(t1y));
    const f32x2 t1 = (f32x2){t1x, t1y};
    const int lo = tid & 1, hi = tid >> 1;
    f32x2* pb = buf + hi * 34 + lo;
    f32x2 x[16];
#pragma unroll
    for (int j = 0; j < 16; ++j) x[j] = pb[j * 2];
    bfly16<false>(x, t1);
#pragma unroll
    for (int j = 0; j < 16; ++j) { const f32x2 rc = (f32x2){dpp_swap1(x[j].x), dpp_swap1(x[j].y)}; x[j] = lo ? rc - x[j] : x[j] + rc; }
    if (MODE != 0) {
        const f32x2* hb = hbuf + hi * 34 + lo;
#pragma unroll
        for (int j = 0; j < 16; ++j) { const int m = hi * 16 + j;
            const f32x2 f = hb[j * 2];
            const int k0 = (int)(__brev((unsigned)m) >> 20), mp = (int)(__brev((unsigned)((4096 - k0) & 4095)) >> 20);
            const int pp = m == 0 ? lo : 2 * mp + (1 - lo);
            const f32x2 gq = hbuf[padi(pp)]; const f32x2 g = (f32x2){gq.x, -gq.y};
            f32x2 h; if (MODE == 1) h = f + g; else { const f32x2 d = f - g; h = (f32x2){d.y, -d.x}; }
            x[j] = cmul(x[j], h); }
#pragma unroll
        for (int j = 0; j < 16; ++j) { const f32x2 rc = (f32x2){dpp_swap1(x[j].x), dpp_swap1(x[j].y)}; x[j] = lo ? rc - x[j] : x[j] + rc; }
        bfly16<true>(x, t1);
    }
#pragma unroll
    for (int j = 0; j < 16; ++j) pb[j * 2] = x[j];
}
template <int MODE> DEVI void fft_mid(f32x2* buf, const f32x2* hbuf, int tid_) {
    int tid = tid_; asm volatile("" : "+v"(tid));
#pragma unroll
    for (int k = 0; k < 8; ++k) { const int m = tid + 512 * k, idx = padi(2 * m);
        const f32x4 v = *(const f32x4*)(buf + idx); f32x2 a = (f32x2){v[0], v[1]}, b = (f32x2){v[2], v[3]}; f32x2 x0 = a + b, x1 = a - b;
        if (MODE != 0) {
            const f32x4 hv = *(const f32x4*)(hbuf + idx);
            const int k0 = (int)(__brev((unsigned)m) >> 20), mp = (int)(__brev((unsigned)((4096 - k0) & 4095)) >> 20);
            const f32x4 pv = *(const f32x4*)(hbuf + padi(2 * mp));
            const f32x2 f0 = (f32x2){hv[0], hv[1]}, f1 = (f32x2){hv[2], hv[3]};
            const f32x2 g0 = m == 0 ? (f32x2){hv[0], -hv[1]} : (f32x2){pv[2], -pv[3]};
            const f32x2 g1 = m == 0 ? (f32x2){hv[2], -hv[3]} : (f32x2){pv[0], -pv[1]};
            f32x2 h0, h1;
            if (MODE == 1) { h0 = f0 + g0; h1 = f1 + g1; }
            else { const f32x2 d0 = f0 - g0, d1 = f1 - g1; h0 = (f32x2){d0.y, -d0.x}; h1 = (f32x2){d1.y, -d1.x}; }
            const f32x2 y0 = cmul(x0, h0), y1 = cmul(x1, h1); x0 = y0 + y1; x1 = y0 - y1; }
        *(f32x4*)(buf + idx) = (f32x4){x0.x, x0.y, x1.x, x1.y}; }
}
DEVI void sconv8(const bf16_t* row, int t0, int rowmask, float w0, float w1, float w2, float bias, float* out) {
    float u[10]; unpack8(*(const u32x4*)(row + t0), u + 1);
    { const bool el = (t0 & rowmask) == 0, er = ((t0 + 8) & rowmask) == 0; const bf16_t vl = row[t0 - 1 + (el ? 1 : 0)], vr = row[t0 + 8 - (er ? 1 : 0)];
      u[0] = el ? 0.f : bf2f(vl); u[9] = er ? 0.f : bf2f(vr); }
#pragma unroll
    for (int e = 0; e < 8; ++e) out[e] = w0 * u[e] + w1 * u[e + 1] + w2 * u[e + 2] + bias;
}

struct Raw8 { u32x4 m; unsigned l, r; };
DEVI Raw8 raw8_load(const bf16_t* row, int t0, bool nb) { Raw8 x; x.m = *(const u32x4*)(row + t0); x.l = 0u; x.r = 0u;
    if (nb) { const bool el = (t0 & 63) == 0, er = ((t0 + 8) & 63) == 0;
        const unsigned vl = row[t0 - 1 + (el ? 1 : 0)], vr = row[t0 + 8 - (er ? 1 : 0)]; x.l = el ? 0u : vl; x.r = er ? 0u : vr; } return x; }
DEVI void sconv8_fin(const Raw8& x, float w0, float w1, float w2, float bias, float* out) {
    float u[10]; unpack8(x.m, u + 1); u[0] = __uint_as_float(x.l << 16); u[9] = __uint_as_float(x.r << 16);
#pragma unroll
    for (int e = 0; e < 8; ++e) out[e] = w0 * u[e] + w1 * u[e + 1] + w2 * u[e + 2] + bias;
}

DEVI void hyena_phase(const Params& p, int layer, bf16_t* Hch, bf16_t* TAPS, float* INVN, const float* H2l, const float* H2c, bool do_ctx, unsigned char* smem) {
    taps_own(p, layer, H2l, TAPS, INVN, smem);
    f32x2* bufA = (f32x2*)smem;
    f32x2* bufH = (f32x2*)(smem + 69632);
    float* sred = (float*)(smem + 139264);
    const int tid = otid(), lane = tid & 63, wid = tid >> 6, t0 = tid * 8;
    const float* cw = p.in[18] + layer * 3 * 3072; const float* cb = p.in[19] + layer * 3072;
    f32x2* twt = (f32x2*)(smem + 139264 + 256);
    twt[tid] = twid(tid, 1.f / 8192.f); if (tid < 32) twt[512 + tid] = twid(tid << 4, 1.f / 8192.f);
    __syncthreads();
#define tw0 (twt[tid])
#define tw4 (twt[512 + (tid & 31)])
#define tw8 ((tid & 1) ? (f32x2){0.9807852804032304f, -0.19509032201612825f} : (f32x2){1.f, 0.f})
    u32x4 tw_[4]; float invn0, invn1;
#define HY_TAPS(cn_) do { _Pragma("unroll") for (int q_ = 0; q_ < 4; ++q_) tw_[q_] = *(const u32x4*)(TAPS + ((size_t)(q_ * 1024 + (cn_))) * 4096 + t0); invn0 = INVN[(cn_)]; invn1 = INVN[1024 + (cn_)]; } while (0)
    for (int c = blockIdx.x; c < 1024; c += gridDim.x) {
        bf16_t* vrow = Hch + (size_t)c * MTOT;
        const float vw0 = cw[c], vw1 = cw[3072 + c], vw2 = cw[6144 + c], vb = cb[c];
        HY_TAPS(c);
        { float f0[8], b0[8], f1[8], b1[8]; unpack8(tw_[0], f0); unpack8(tw_[1], b0); unpack8(tw_[2], f1); unpack8(tw_[3], b1);
#pragma unroll
          for (int e = 0; e < 8; ++e) { bufH[padi(t0 + e)] = (f32x2){f0[e] * invn0, f1[e] * invn1}; const int m = t0 + e;
              if (m >= 1) bufH[padi(8192 - m)] = (f32x2){b0[e] * invn0, b1[e] * invn1}; else bufH[padi(4096)] = (f32x2){0.f, 0.f}; } }
        Raw8 za = raw8_load(vrow, t0, true), zb = raw8_load(vrow + 4096, t0, true);
        __syncthreads();
        fft_pass<0, false>(bufH, tid, tw0); __syncthreads(); fft_pass<4, false>(bufH, tid, tw4); __syncthreads(); fft_mid3<0>(bufH, bufH, tid, tw8); __syncthreads();
        for (int o = 0; o < 2; ++o) {
            const int gch = (o + 1) * 1024 + c; const bf16_t* grow = Hch + (size_t)gch * MTOT;
            const float gw0 = cw[gch], gw1 = cw[3072 + gch], gw2 = cw[6144 + gch], gb = cb[gch];
            const float bias = p.in[27][(layer * 2 + o) * 1024 + c];
            for (int pr = 0; pr < 2; ++pr) {
                float z0[8], z1[8];
                if (o == 0) { sconv8_fin(za, vw0, vw1, vw2, vb, z0); sconv8_fin(zb, vw0, vw1, vw2, vb, z1); }
                else { unpack8(za.m, z0); unpack8(zb.m, z1); }
#pragma unroll
                for (int e = 0; e < 8; ++e) bufA[padi(t0 + e)] = (f32x2){z0[e], z1[e]};
                __syncthreads();
                fft_pass<0, false, true>(bufA, tid, tw0); __syncthreads(); fft_pass<4, false>(bufA, tid, tw4); __syncthreads();
                if (o == 0) fft_mid3<1>(bufA, bufH, tid, tw8); else fft_mid3<2>(bufA, bufH, tid, tw8);
                __syncthreads();
                const Raw8 ga = raw8_load(grow + (2 * pr) * 4096, t0, true), gc = raw8_load(grow + (2 * pr + 1) * 4096, t0, true);
                if (pr == 0) { za = raw8_load(vrow + 2 * 4096, t0, o == 0); zb = raw8_load(vrow + 3 * 4096, t0, o == 0); }
                fft_pass<4, true>(bufA, tid, tw4); __syncthreads(); fft_pass<0, true, true>(bufA, tid, tw0); __syncthreads();
                float g0[8], g1[8], r0[8], r1[8];
                sconv8_fin(ga, gw0, gw1, gw2, gb, g0); sconv8_fin(gc, gw0, gw1, gw2, gb, g1);
#pragma unroll
                for (int e = 0; e < 8; ++e) { const f32x2 y = bufA[padi(t0 + e)]; r0[e] = g0[e] * (y.x * (1.f / 16384.f) + bias * z0[e]); r1[e] = g1[e] * (y.y * (1.f / 16384.f) + bias * z1[e]); }
                *(u32x4*)(vrow + (2 * pr) * 4096 + t0) = pack8(r0); *(u32x4*)(vrow + (2 * pr + 1) * 4096 + t0) = pack8(r1);
                if (o == 0 && pr == 1) { __syncthreads(); za = raw8_load(vrow, t0, false); zb = raw8_load(vrow + 4096, t0, false); }
                __syncthreads();
            }
        }
        if (do_ctx) {
            float* hh = (float*)smem;
            float* zc = hh + 1024;
            float* g1c = zc + 1024; float* g2c = g1c + 1024; float* z2c = g2c + 1024;
            float* w3c = z2c + 1024;
            const float* w3 = p.in[26] + (size_t)layer * 64 * 4096;
            if (tid < 256) { const int j = tid >> 2, q = tid & 3; w3c[tid] = w3[j * 4096 + (q >> 1) * 2048 + (q & 1) * 1024 + c]; }
            if (tid < 384) { const int which = tid >> 7, rem = tid & 127, b = rem >> 5, tt = (rem & 31) * 8; const int ch = which * 1024 + c;
                float ov[8]; sconv8(Hch + (size_t)ch * MTOT + MLAT + b * 256, tt, 255, cw[ch], cw[3072 + ch], cw[6144 + ch], cb[ch], ov);
                float* dst = (which == 0 ? zc : which == 1 ? g1c : g2c) + b * 256 + tt;
#pragma unroll
                for (int e = 0; e < 8; ++e) dst[e] = ov[e]; }
            __syncthreads();
            { const int t = tid & 255, dir = tid >> 8; float a0 = 0.f, a1 = 0.f; const float* hr = H2c + t * 64;
#pragma unroll
              for (int j4 = 0; j4 < 16; ++j4) { const f32x4 hv = *(const f32x4*)(hr + j4 * 4);
#pragma unroll
                  for (int jj = 0; jj < 4; ++jj) { const float* wq = w3c + (j4 * 4 + jj) * 4 + dir * 2; a0 += hv[jj] * wq[0]; a1 += hv[jj] * wq[1]; } }
              const float win = __expf(-((float)t * (1.f / 255.f)) * hy_delta(c)); a0 *= win; a1 *= win;
              if (dir == 0) { hh[255 + t] = a0; hh[512 + 255 + t] = a1; } else if (t >= 1) { hh[255 - t] = a0; hh[512 + 255 - t] = a1; }
              if (tid == 0) { hh[511] = 0.f; hh[1023] = 0.f; }
              float s0 = (dir == 1 && t == 0) ? 0.f : fabsf(a0), s1 = (dir == 1 && t == 0) ? 0.f : fabsf(a1);
              s0 = wave_sum(s0, lane); s1 = wave_sum(s1, lane); if (lane == 0) { sred[wid * 2] = s0; sred[wid * 2 + 1] = s1; } }
            __syncthreads();
            float inv0, inv1; { float s0 = 0.f, s1 = 0.f; for (int w = 0; w < 8; ++w) { s0 += sred[w * 2]; s1 += sred[w * 2 + 1]; } inv0 = 1.f / (s0 + 1e-6f); inv1 = 1.f / (s1 + 1e-6f); }
            const float bias0 = p.in[27][(layer * 2 + 0) * 1024 + c], bias1 = p.in[27][(layer * 2 + 1) * 1024 + c];
            const int t = tid & 255, bb = tid >> 8;
#pragma unroll 1
            for (int o = 0; o < 2; ++o) {
                const float* hq = hh + o * 512 + t + 255; const float* zin = (o == 0 ? zc : z2c) + bb * 256; const float* gin = (o == 0 ? g1c : g2c) + bb * 256;
                float y0 = 0.f, y1 = 0.f;
#pragma unroll 8
                for (int s2 = 0; s2 < 256; ++s2) { const float h = hq[-s2]; y0 += h * zin[s2]; y1 += h * zin[512 + s2]; }
                const float inv = o == 0 ? inv0 : inv1, bias = o == 0 ? bias0 : bias1;
                const float r0 = gin[t] * (y0 * inv + bias * zin[t]), r1 = gin[512 + t] * (y1 * inv + bias * zin[512 + t]);
                if (o == 0) { __syncthreads(); z2c[bb * 256 + t] = r0; z2c[(bb + 2) * 256 + t] = r1; }
                else { Hch[(size_t)c * MTOT + MLAT + bb * 256 + t] = f2bf(r0); Hch[(size_t)c * MTOT + MLAT + (bb + 2) * 256 + t] = f2bf(r1); }
                __syncthreads();
            }
        }
    }
}

#undef tw0
#undef tw4
#undef tw8
#define XB_TMO      128
#define XB_XCNT(j)  (256  + 64 * (j))
#define XB_XSUB(j)  (1280 + 64 * (j))
#define XB_XGEN(j)  (2304 + 64 * (j))
#define XB_TOP      3328
#define XB_TOPGEN   3392
#define XCD_BAR_WORDS 3456
#define XB_SPIN_CAP (1u << 20)
DEVI unsigned xb_ld(unsigned* p)              { return __hip_atomic_load(p, __ATOMIC_RELAXED, __HIP_MEMORY_SCOPE_AGENT); }
DEVI unsigned xb_add(unsigned* p, unsigned v) { return __hip_atomic_fetch_add(p, v, __ATOMIC_RELAXED, __HIP_MEMORY_SCOPE_AGENT); }
DEVI unsigned xb_xcc_id() { return (unsigned)__builtin_amdgcn_s_getreg((3 << 11) | 20) & 0xFu; }
#define XB_SPIN(cond, bar) do { unsigned _sp = 0; while (cond) { __builtin_amdgcn_s_sleep(1); \
    if ((++_sp & 255u) == 0u) { if (xb_ld(&(bar)[XB_TMO])) break; if (_sp > XB_SPIN_CAP) { atomicAdd(&(bar)[XB_TMO], 1u); break; } } } } while (0)
struct XcdBarrier { unsigned* bar; unsigned x; volatile LAS unsigned* st; };
DEVI XcdBarrier xcd_barrier_post(unsigned* bar, volatile LAS unsigned* st) {
    XcdBarrier b; b.bar = bar; b.x = xb_xcc_id(); b.st = st;
    if (threadIdx.x == 0) (void)xb_add(&bar[XB_XCNT(b.x)], 1u);
    return b;
}
DEVI void xcd_barrier_complete(unsigned* bar, unsigned x, unsigned& nloc, unsigned& nx) {
    const unsigned G = gridDim.x * gridDim.y * gridDim.z;
    unsigned sum, cnt, mine, sp = 0u;
    for (;;) {
        sum = 0u; cnt = 0u; mine = 0u;
#pragma unroll
        for (unsigned j = 0; j < 16; ++j) { const unsigned c = xb_ld(&bar[XB_XCNT(j)]); sum += c; cnt += (c > 0u) ? 1u : 0u; mine = (j == x) ? c : mine; }
        if (sum == G) break;
        __builtin_amdgcn_s_sleep(1);
        if ((++sp & 255u) == 0u) { if (xb_ld(&bar[XB_TMO])) break; if (sp > XB_SPIN_CAP) { atomicAdd(&bar[XB_TMO], 1u); break; } }
    }
    nloc = mine > 0u ? mine : 1u; nx = cnt > 0u ? cnt : 1u;
}
DEVI void xcd_barrier(const XcdBarrier& b) {
    asm volatile("s_waitcnt vmcnt(0)" ::: "memory");
    __syncthreads();
    if (threadIdx.x == 0) {
        unsigned* bar = b.bar;
        __builtin_amdgcn_s_waitcnt(0);
        unsigned nloc = b.st[0], nx = b.st[1];
        if (nloc == 0u) { xcd_barrier_complete(bar, b.x, nloc, nx); b.st[0] = nloc; b.st[1] = nx; }
        const unsigned old = xb_add(&bar[XB_XSUB(b.x)], 1u);
        const unsigned gen = old / nloc;
        if (old + 1u == (gen + 1u) * nloc) {
            __builtin_amdgcn_fence(__ATOMIC_RELEASE, "agent");
            asm volatile("s_waitcnt vmcnt(0)" ::: "memory");
            const unsigned og = xb_add(&bar[XB_TOP], 1u);
            const unsigned tg = og / nx;
            if (og + 1u == (tg + 1u) * nx) xb_add(&bar[XB_TOPGEN], 1u);
            else XB_SPIN(xb_ld(&bar[XB_TOPGEN]) == tg, bar);
            __builtin_amdgcn_fence(__ATOMIC_ACQUIRE, "agent");
            xb_add(&bar[XB_XGEN(b.x)], 1u);
            asm volatile("s_waitcnt vmcnt(0)" ::: "memory");
        } else {
            XB_SPIN(xb_ld(&bar[XB_XGEN(b.x)]) == gen, bar);
            __builtin_amdgcn_fence(__ATOMIC_ACQUIRE, "agent");
            asm volatile("s_waitcnt vmcnt(0)" ::: "memory");
        }
    }
    __syncthreads();
}

__global__ void __launch_bounds__(512) hybrid_forward(Params p) {
    extern __shared__ __attribute__((aligned(16))) unsigned char shm[];
    cg::grid_group grid = cg::this_grid();
    unsigned char* ws = p.ws;
    float* X = (float*)(ws + WS_X);
    unsigned char* R = ws + WS_R; unsigned char* W = ws + WS_W;
    float* MOD = (float*)(ws + WS_MOD); float* H2 = (float*)(ws + WS_H2); float* INVN = (float*)(ws + WS_INVN);
    bf16_t* Hn = (bf16_t*)p.out;
    bf16_t* ACT = (bf16_t*)(R + R_ACT); bf16_t* Pg = (bf16_t*)(R + R_PG); bf16_t* Ob = (bf16_t*)(R + R_OB); bf16_t* Hch = (bf16_t*)(R + R_HCH);
    bf16_t* G = (bf16_t*)(R + R_G); bf16_t* Of = (bf16_t*)(R + R_OF); float* T1 = (float*)(R + R_T1); bf16_t* Am = (bf16_t*)(R + R_AM);
    bf16_t* TAPS = (bf16_t*)(W + W_GU1);
    bf16_t* QF = (bf16_t*)(R + 4 * U + U / 4);
    float* DEC = (float*)(R + 4 * U + U / 4 + U / 2);
    bf16_t* KF = (bf16_t*)((unsigned char*)p.out + U);
    bf16_t* ATTf = (bf16_t*)(W + W_GU1);
    bf16_t* ATTb = (bf16_t*)((unsigned char*)p.out + U + U / 2);
    float* PART = (float*)(R + 3 * U);

    { volatile LAS unsigned* st = (volatile LAS unsigned*)(LAS unsigned char*)(shm + LDS_BYTES - 16); if (otid() == 0) { st[0] = 0u; st[1] = 0u; st[2] = 0u; st[3] = 0u; } }
    __syncthreads();
    const XcdBarrier xb = xcd_barrier_post((unsigned*)(ws + WS_BAR), (volatile LAS unsigned*)(LAS unsigned char*)(shm + LDS_BYTES - 16));
    if (otid() == 0) { volatile LAS unsigned* st = (volatile LAS unsigned*)(LAS unsigned char*)(shm + LDS_BYTES - 16); st[2] = xb_add((unsigned*)(ws + WS_BAR) + 3520 + 64 * xb.x, 1u); }
    xinit_phase(p, X); mod_phase(p, MOD, shm); h2_phase(p, H2, shm); convert_phase(p, 0, W, shm);
    grid.sync();
    int vc = -1;
    { unsigned* bar = (unsigned*)(ws + WS_BAR); bool even = gridDim.x == 256u;
      for (int j = 0; j < 8; ++j) even = even && (xb_ld(&bar[XB_XCNT(j)]) == 32u);
      const unsigned rank = ((volatile LAS unsigned*)(LAS unsigned char*)(shm + LDS_BYTES - 16))[2];
      if (even && rank < 32u && xb.x < 8u) vc = (int)(rank * 8u + xb.x);
      vc = __builtin_amdgcn_readfirstlane(vc); }
#pragma unroll 1
    for (int layer = 0; layer < 2; ++layer) {
        const bool last = layer == 1; const int Mmix = last ? MLAT : MTOT;
        const float* modl = MOD + layer * 5 * 9216;
        if (layer > 0) convert_phase(p, layer, W, shm);
        if (LIMIT & 1) norm_phase(X, Hn, p.in[6] + layer * 1024, modl, 0, 1, MTOT, PART, layer > 0 ? 11 : 0, layer == 0 ? p.in[0] : nullptr);
        xcd_barrier(xb);
        if (LIMIT & 1) { EpiSwiglu E; E.O = ACT; run_gemm(shm, Hn, (const bf16_t*)(W + W_GU1), MTOT, 2 * DFF, 1024, E); }
        xcd_barrier(xb);
        if (LIMIT & 1) { EpiResid E; E.X = X; E.mod = modl; E.Xin = layer == 0 ? p.in[0] : X; E.idx = 2; E.scale = 0.5f; E.part = PART; run_gemm_split(shm, ACT, (const bf16_t*)(W + W_D1), MLAT, MTOT, 1024, DFF, E); }
        xcd_barrier(xb);
        if (LIMIT & 2) norm_phase(X, Hn, p.in[10] + layer * 1024, modl, 3, 4, MTOT, PART, 11);
        xcd_barrier(xb);
        if (LIMIT & 2) { EpiBf16<0> E; E.O = Pg; E.ldc = PGW; run_gemm(shm, Hn, (const bf16_t*)(W + W_IN), MTOT, PGW, 1024, E); }
        xcd_barrier(xb);
        if (LIMIT & 4) gla_prep_phase(p, layer, vc, Pg, QF, KF, DEC, ATTf, ATTb, shm);
        xcd_barrier(xb);
        if (LIMIT & 4) gla_phase(p, layer, vc, Pg, QF, KF, DEC, ATTf, ATTb, Of, Ob, shm);
        xcd_barrier(xb);
        if (LIMIT & 4) gla_post_phase(p, layer, Pg, Of, Ob, Mmix);
        xcd_barrier(xb);
        if (LIMIT & 8) { EpiBf16<0> E; E.O = Hch; E.ldc = MTOT; run_gemm(shm, (const bf16_t*)(W + W_IN) + (size_t)PGW * 1024, Hn, 3072, Mmix, 1024, E); }
        if (LIMIT & 8) { EpiBf16<1> E; E.O = G; E.ldc = 2048; run_gemm(shm, Hn, (const bf16_t*)(W + W_IN) + (size_t)6400 * 1024, Mmix, 2048, 1024, E, true); }
        xcd_barrier(xb);
        if (LIMIT & 16) hyena_phase(p, layer, Hch, TAPS, INVN, H2 + (size_t)layer * 4352 * 64, H2 + ((size_t)layer * 4352 + 4096) * 64, !last, shm);
        xcd_barrier(xb);
        if (LIMIT & 16) transpose_phase(Hch, Hn, Mmix, shm);
        xcd_barrier(xb);
        if (LIMIT & 32) { EpiGateA E; E.T1 = T1; E.G = G; run_gemm(shm, Of, (const bf16_t*)(W + W_GO), Mmix, 1024, 1024, E); }
        if (LIMIT & 32) { EpiGateB E; E.T1 = T1; E.G = G; E.Am = Am; run_gemm(shm, Hn, (const bf16_t*)(W + W_HO), Mmix, 1024, 1024, E); }
        xcd_barrier(xb);
        if (LIMIT & 32) { EpiResid E; E.X = X; E.mod = modl; E.Xin = X; E.idx = 5; E.scale = 1.0f; E.part = PART; run_gemm_split(shm, Am, (const bf16_t*)(W + W_O), MLAT, Mmix, 1024, 1024, E); }
        xcd_barrier(xb);
        if (LIMIT & 64) norm_phase(X, Hn, p.in[30] + layer * 1024, modl, 6, 7, Mmix, PART, 4);
        xcd_barrier(xb);
        if (LIMIT & 64) { EpiSwiglu E; E.O = ACT; run_gemm(shm, Hn, (const bf16_t*)(W + W_GU2), Mmix, 2 * DFF, 1024, E); }
        xcd_barrier(xb);
        if (LIMIT & 64) { EpiResid E; E.X = X; E.mod = modl; E.Xin = X; E.idx = 8; E.scale = 0.5f; E.part = PART; run_gemm_split(shm, ACT, (const bf16_t*)(W + W_D2), MLAT, Mmix, 1024, DFF, E); }
        xcd_barrier(xb);
    }
    final_norm_phase(X, p.out, p.in[34]);
}

extern "C" void kernel_launch(void* const* d_in, const int* in_sizes, int n_in, void* d_out, int out_size, void* d_ws, size_t ws_size, hipStream_t stream) {
    static int grid_blocks = 0;
    if (!grid_blocks) {
        int dev = 0, cus = 0, per_cu = 0;
        hipGetDevice(&dev);
        hipDeviceGetAttribute(&cus, hipDeviceAttributeMultiprocessorCount, dev);
        hipFuncSetAttribute((const void*)hybrid_forward, hipFuncAttributeMaxDynamicSharedMemorySize, LDS_BYTES);
        hipOccupancyMaxActiveBlocksPerMultiprocessor(&per_cu, (const void*)hybrid_forward, 512, LDS_BYTES);
        if (per_cu < 1) per_cu = 1;
        grid_blocks = cus * per_cu;
        if (ws_size < WS_END) fprintf(stderr, "kernel_launch: workspace too small: %zu < %zu\n", ws_size, (size_t)WS_END);
    }
    (void)hipMemsetAsync((unsigned char*)d_ws + WS_BAR, 0, 16384, stream);
    Params p{};
    for (int i = 0; i < 35; ++i) p.in[i] = (const float*)d_in[i];
    p.out = (float*)d_out; p.ws = (unsigned char*)d_ws;
    void* args[] = {&p};
    hipError_t e = hipLaunchCooperativeKernel((const void*)hybrid_forward, dim3(grid_blocks), dim3(512), args, LDS_BYTES, stream);
    if (e != hipSuccess) fprintf(stderr, "cooperative launch failed: %s (grid %d)\n", hipGetErrorString(e), grid_blocks);
}
```

```cpp
#include <hip/hip_runtime.h>
#include <hip/hip_cooperative_groups.h>
#include <cstdio>
namespace cg = cooperative_groups;

#define DEVI __device__ __forceinline__
#define LAS __attribute__((address_space(3)))
typedef unsigned short bf16_t;
typedef short bf16x8 __attribute__((ext_vector_type(8)));
typedef float f32x4 __attribute__((ext_vector_type(4)));
typedef float f32x2 __attribute__((ext_vector_type(2)));
typedef unsigned u32x4 __attribute__((ext_vector_type(4)));
typedef unsigned u32x2 __attribute__((ext_vector_type(2)));

constexpr int MLAT = 16384, MTOT = 17408, DM = 1024, DFF = 2816, INW = 8224;
constexpr int PGW = 3328;
constexpr size_t U = (size_t)MTOT * 1024 * 2;
constexpr size_t WS_X = 0;
constexpr size_t WS_R = (size_t)MTOT * 1024 * 4;
constexpr size_t WS_W = WS_R + 6 * U;
constexpr size_t W_GU1 = 0, W_D1 = 11534336, W_IN = 17301504, W_GO = 34603008, W_HO = 36700160, W_O = 38797312, W_GU2 = 40894464, W_D2 = 52428800, W_END = 58195968;
constexpr size_t WS_MOD = WS_W + W_END;
constexpr size_t WS_H2 = WS_MOD + 2 * 5 * 9216 * 4;
constexpr size_t WS_INVN = WS_H2 + (size_t)2 * 4352 * 64 * 4;
constexpr size_t WS_BAR = WS_INVN + 8192;
constexpr size_t WS_END = WS_BAR + 16384;
constexpr size_t R_ACT = 0, R_PG = 0, R_OB = 115867648, R_HCH = 0, R_G = 3 * U, R_OF = 5 * U, R_T1 = U, R_AM = 0;
constexpr int LDS_BYTES = 147456;
#ifndef GCONST
#define GCONST 0
#endif
#ifndef LIMIT
#define LIMIT 127
#endif

struct Params { const float* in[35]; float* out; unsigned char* ws; };

DEVI int otid() { int t = threadIdx.x; asm volatile("" : "+v"(t)); return t; }
typedef __bf16 bf16x2_t __attribute__((ext_vector_type(2)));
DEVI unsigned cvt_pk_bf16(float lo, float hi) { bf16x2_t v = {(__bf16)lo, (__bf16)hi}; return __builtin_bit_cast(unsigned, v); }
DEVI bf16_t f2bf(float f) { return (bf16_t)(cvt_pk_bf16(f, 0.f) & 0xffffu); }
DEVI float bf2f(bf16_t b) { return __uint_as_float(((unsigned)b) << 16); }
DEVI float bflo(unsigned w) { return __uint_as_float(w << 16); }
DEVI float bfhi(unsigned w) { return __uint_as_float(w & 0xffff0000u); }
DEVI float silu_f(float x) { return x * __builtin_amdgcn_rcpf(1.f + __expf(-x)); }
DEVI float sigmoid_f(float x) { return __builtin_amdgcn_rcpf(1.f + __expf(-x)); }
DEVI void unpack8(u32x4 w, float* o) { o[0] = bflo(w.x); o[1] = bfhi(w.x); o[2] = bflo(w.y); o[3] = bfhi(w.y); o[4] = bflo(w.z); o[5] = bfhi(w.z); o[6] = bflo(w.w); o[7] = bfhi(w.w); }
DEVI u32x4 pack8(const float* v) { u32x4 w; w.x = cvt_pk_bf16(v[0], v[1]); w.y = cvt_pk_bf16(v[2], v[3]); w.z = cvt_pk_bf16(v[4], v[5]); w.w = cvt_pk_bf16(v[6], v[7]); return w; }

namespace pg8 {
constexpr int BM = 256, BK = 64, HALF = 128, HTB = HALF * BK * 2, STAGE_BYTES = 8 * HTB, NXCD = 8, WGM = 8;
DEVI int lds_byte(int r, int c) { const int st = (r >> 4) * 2 + (c >> 5), rr = r & 15, cc = c & 31, ob = rr * 64 + cc * 2; return st * 1024 + (ob ^ (((ob >> 9) & 1) << 5)); }
DEVI void stage_rc(int b, int& R, int& C) { const int st = b / 1024, sb = b % 1024, swz = sb ^ (((sb >> 9) & 1) << 5); R = (st >> 1) * 16 + swz / 64; C = (st & 1) * 32 + (swz % 64) / 2; }
DEVI int perm32(int rho) { const int n = rho >> 4, i = rho & 15; return 8 * (i >> 2) + 4 * n + (i & 3); }
struct Unit { int pm, pn, k0, nt; };
struct Gemm { const bf16_t* A; const bf16_t* Bt; int M, N, K; };
struct StaticOrder {
    int nM, nN, nwg, G, c, ntf;
    DEVI void init(int M, int N, int K, int G_, int c_) { nM = M / BM; nN = N / BM; nwg = nM * nN; G = G_; c = c_; ntf = K / BK; }
    DEVI bool next(int i, Unit& u) const {
        const long L = (long)i * G + c; if (L >= nwg) return false;
        int wgid = (int)L; { const int q = nwg / NXCD, r = nwg % NXCD, xcd = wgid % NXCD, off = wgid / NXCD; wgid = (xcd < r ? xcd * (q + 1) : r * (q + 1) + (xcd - r) * q) + off; }
        const int nig = WGM * nN, gid = wgid / nig, fm = gid * WGM, gsz = (nM - fm) < WGM ? (nM - fm) : WGM;
        u.pm = fm + ((wgid % nig) % gsz); u.pn = (wgid % nig) / gsz; u.k0 = 0; u.nt = ntf; return true;
    }
};
struct SplitOrder {
    StaticOrder full; int nN, nsl, nsub, nMf;
    DEVI void init(int Mfull, int Mtot, int N, int K, int G_, int c_) { full.init(Mfull, N, K, G_, c_); nN = N / BM; nMf = Mfull / BM; nsl = K / 256; nsub = ((Mtot - Mfull) / BM) * nN * nsl; }
    DEVI bool next(int i, Unit& u) const {
        const long L = (long)i * full.G + full.c; if (L < full.nwg) return full.next(i, u);
        const int j = (int)(L - full.nwg); if (j >= nsub) return false;
        const int sl = j % nsl, t = j / nsl; u.pn = t % nN; u.pm = nMf + t / nN; u.k0 = sl * 256; u.nt = 4; return true;
    }
};

template <class Epi, class Sched>
DEVI void gemm_phase(LAS unsigned char* lds, const Gemm g, const Sched& S, const Epi& E) {
    const int tid = otid(), wid = __builtin_amdgcn_readfirstlane(tid >> 6), lane = tid & 63, wr = wid >> 2, wc = wid & 3, fr = lane & 15, fq = lane >> 4;
    const int K = g.K;
    unsigned voffA[2], voffB[2];
#pragma unroll
    for (int i = 0; i < 2; ++i) { int R, C; stage_rc(tid * 16 + i * 8192, R, C); const int Rb = Epi::PERM ? ((R & ~31) + perm32(R & 31)) : R;
        voffA[i] = (unsigned)(R * K + C) * 2u; voffB[i] = (unsigned)(Rb * K + C) * 2u; }
    const size_t kstep = (size_t)(BK * 2);
    const size_t hstep = (size_t)HALF * K * 2;
    const size_t tstep = 2 * hstep;
    const unsigned ldsw = (unsigned)wid * 1024u;
    const int aoff = lds_byte(wr * 64 + fr, fq * 8), boff = lds_byte(wc * 32 + fr, fq * 8);
#define PG8_SA(b, h) (((b) * 2 + (h)) * HTB)
#define PG8_SB(b, h) ((4 + (b) * 2 + (h)) * HTB)
#define PG8_STAGE(bufoff, gbase, voff) do { _Pragma("unroll") for (int _i = 0; _i < 2; ++_i) \
        __builtin_amdgcn_global_load_lds((const unsigned*)((const char*)(gbase) + (voff)[_i]), (LAS unsigned*)(lds + (bufoff) + ldsw + _i * 8192), 16, 0, 0); } while (0)
#define PG8_LDA(dst, b, h) do { _Pragma("unroll") for (int m = 0; m < 4; ++m) _Pragma("unroll") for (int k = 0; k < 2; ++k) dst[m][k] = *(const LAS bf16x8*)(lds + PG8_SA(b, h) + aoff + m * 2048 + k * 1024); } while (0)
#define PG8_LDB(dst, b, h) do { _Pragma("unroll") for (int n = 0; n < 2; ++n) _Pragma("unroll") for (int k = 0; k < 2; ++k) dst[n][k] = *(const LAS bf16x8*)(lds + PG8_SB(b, h) + boff + n * 2048 + k * 1024); } while (0)
#define PG8_MMA(ai, bj, At, Bt) do { __builtin_amdgcn_s_setprio(1); _Pragma("unroll") for (int m = 0; m < 4; ++m) _Pragma("unroll") for (int n = 0; n < 2; ++n) _Pragma("unroll") for (int k = 0; k < 2; ++k) \
        acc[ai][bj][m][n] = __builtin_amdgcn_mfma_f32_16x16x32_bf16(Bt[n][k], At[m][k], acc[ai][bj][m][n], 0, 0, 0); __builtin_amdgcn_s_setprio(0); } while (0)
#define PG8_WAIT_V(n) asm volatile("s_waitcnt vmcnt(" #n ")" ::: "memory")
#define PG8_WAIT_L(n) asm volatile("s_waitcnt lgkmcnt(" #n ")" ::: "memory")
#define PG8_BAR __builtin_amdgcn_s_barrier()
#define PG8_SCHED __builtin_amdgcn_sched_barrier(0)
    Unit cur, nxt; int ui = 0;
    if (!S.next(0, cur)) return;
    f32x4 acc[2][2][4][2];
#pragma unroll
    for (int a = 0; a < 2; ++a)
#pragma unroll
        for (int b = 0; b < 2; ++b)
#pragma unroll
            for (int m = 0; m < 4; ++m)
#pragma unroll
                for (int n = 0; n < 2; ++n) acc[a][b][m][n] = (f32x4){0.f, 0.f, 0.f, 0.f};
    bf16x8 At[4][2], B0[2][2], B1[2][2];
    const char* cA = (const char*)g.A + (size_t)cur.pm * tstep + (size_t)cur.k0 * 2; const char* cB = (const char*)g.Bt + (size_t)cur.pn * tstep + (size_t)cur.k0 * 2;
    PG8_STAGE(PG8_SB(0, 0), cB, voffB); PG8_STAGE(PG8_SA(0, 0), cA, voffA); PG8_STAGE(PG8_SB(0, 1), cB + hstep, voffB); PG8_STAGE(PG8_SA(0, 1), cA + hstep, voffA);
    if (wr == 1) PG8_BAR;
    PG8_WAIT_V(4); PG8_BAR;
    PG8_STAGE(PG8_SB(1, 0), cB + kstep, voffB); PG8_STAGE(PG8_SA(1, 0), cA + kstep, voffA); PG8_STAGE(PG8_SB(1, 1), cB + hstep + kstep, voffB);
    PG8_WAIT_V(6); PG8_BAR;
    for (;;) {
        const bool has_next = S.next(ui + 1, nxt);
        const char* nA = has_next ? (const char*)g.A + (size_t)nxt.pm * tstep + (size_t)nxt.k0 * 2 : cA; const char* nB = has_next ? (const char*)g.Bt + (size_t)nxt.pn * tstep + (size_t)nxt.k0 * 2 : cB;
        const int nt = cur.nt;
        for (int t = 0; t < nt; t += 2) {
            const bool last = (t == nt - 2);
            const char* a1 = cA + (size_t)(t + 1) * kstep;
            const char* a2 = last ? nA : cA + (size_t)(t + 2) * kstep; const char* b2 = last ? nB : cB + (size_t)(t + 2) * kstep;
            const char* a3 = a2 + kstep; const char* b3 = b2 + kstep;
            PG8_LDB(B0, 0, 0); PG8_SCHED; PG8_LDA(At, 0, 0); PG8_STAGE(PG8_SA(1, 1), a1 + hstep, voffA);
            PG8_WAIT_L(8); PG8_BAR; PG8_WAIT_L(0); PG8_MMA(0, 0, At, B0); PG8_BAR; PG8_SCHED;
            PG8_LDB(B1, 0, 1); PG8_STAGE(PG8_SB(0, 0), b2, voffB);
            PG8_BAR; PG8_WAIT_L(0); PG8_MMA(0, 1, At, B1); PG8_BAR;
            PG8_LDA(At, 0, 1); PG8_STAGE(PG8_SA(0, 0), a2, voffA);
            PG8_BAR; PG8_WAIT_L(0); PG8_MMA(1, 0, At, B0); PG8_BAR; PG8_SCHED;
            PG8_STAGE(PG8_SB(0, 1), b2 + hstep, voffB);
            PG8_WAIT_V(6); PG8_BAR; PG8_MMA(1, 1, At, B1); PG8_BAR;
            PG8_LDB(B0, 1, 0); PG8_SCHED; PG8_LDA(At, 1, 0); PG8_STAGE(PG8_SA(0, 1), a2 + hstep, voffA);
            PG8_WAIT_L(8); PG8_BAR; PG8_WAIT_L(0); PG8_MMA(0, 0, At, B0); PG8_BAR; PG8_SCHED;
            PG8_LDB(B1, 1, 1); PG8_STAGE(PG8_SB(1, 0), b3, voffB);
            PG8_BAR; PG8_WAIT_L(0); PG8_MMA(0, 1, At, B1); PG8_BAR;
            PG8_LDA(At, 1, 1); PG8_STAGE(PG8_SA(1, 0), a3, voffA);
            PG8_BAR; PG8_WAIT_L(0); PG8_MMA(1, 0, At, B0); PG8_BAR; PG8_SCHED;
            PG8_STAGE(PG8_SB(1, 1), b3 + hstep, voffB);
            PG8_WAIT_V(6); PG8_BAR; PG8_MMA(1, 1, At, B1); PG8_BAR;
        }
        E(acc, cur, wr, wc, fr, fq);
        if (!has_next) break;
#pragma unroll
        for (int a = 0; a < 2; ++a)
#pragma unroll
            for (int b = 0; b < 2; ++b)
#pragma unroll
                for (int m = 0; m < 4; ++m)
#pragma unroll
                    for (int n = 0; n < 2; ++n) acc[a][b][m][n] = (f32x4){0.f, 0.f, 0.f, 0.f};
        cur = nxt; cA = nA; cB = nB; ++ui;
    }
    PG8_WAIT_V(0);
    if (wr == 0) PG8_BAR;
    PG8_BAR;
#undef PG8_SA
#undef PG8_SB
#undef PG8_STAGE
#undef PG8_LDA
#undef PG8_LDB
#undef PG8_MMA
#undef PG8_WAIT_V
#undef PG8_WAIT_L
#undef PG8_BAR
#undef PG8_SCHED
}
}
using pg8::Unit; using pg8::Gemm; using pg8::StaticOrder; using pg8::HALF; using pg8::BM;
typedef f32x4 AccT[2][2][4][2];

struct EpiSwiglu {
    static constexpr bool PERM = true; bf16_t* O;
    DEVI void operator()(const AccT& acc, const Unit& u, int wr, int wc, int fr, int fq) const {
        const int row0 = u.pm * BM + wr * 64 + fr, j0 = u.pn * HALF + wc * 32 + 8 * fq;
#pragma unroll
        for (int ai = 0; ai < 2; ++ai)
#pragma unroll
            for (int m = 0; m < 4; ++m) { bf16_t* rowp = O + (size_t)(row0 + ai * HALF + m * 16) * DFF + j0;
                const f32x4 g0 = acc[ai][0][m][0], g1 = acc[ai][0][m][1], u0 = acc[ai][1][m][0], u1 = acc[ai][1][m][1];
                u32x4 w; w.x = cvt_pk_bf16(silu_f(g0[0]) * u0[0], silu_f(g0[1]) * u0[1]); w.y = cvt_pk_bf16(silu_f(g0[2]) * u0[2], silu_f(g0[3]) * u0[3]);
                w.z = cvt_pk_bf16(silu_f(g1[0]) * u1[0], silu_f(g1[1]) * u1[1]); w.w = cvt_pk_bf16(silu_f(g1[2]) * u1[2], silu_f(g1[3]) * u1[3]);
                *(u32x4*)rowp = w; }
    }
};
struct EpiResid {
    static constexpr bool PERM = false; float* X; const float* Xin; const float* mod; int idx; float scale; float* part;
    DEVI void operator()(const AccT& acc, const Unit& u, int wr, int wc, int fr, int fq) const {
        const int row0 = u.pm * BM + wr * 64 + fr, col0 = u.pn * BM + wc * 32 + 4 * fq;
        const int brow = u.pm < 64 ? (u.pm >> 4) : 4; const bool split = u.pm >= 64;
        f32x4 gv[2][2];
#pragma unroll
        for (int bj = 0; bj < 2; ++bj)
#pragma unroll
            for (int n = 0; n < 2; ++n) gv[bj][n] = *(const f32x4*)(mod + brow * 9216 + idx * 1024 + col0 + bj * HALF + n * 16) * scale;
        if (split) {
#pragma unroll
            for (int ai = 0; ai < 2; ++ai)
#pragma unroll
                for (int m = 0; m < 4; ++m) { float* pp = part + ((size_t)(u.k0 >> 8) * 1024 + (size_t)(row0 + ai * HALF + m * 16 - MLAT)) * DM + col0;
#pragma unroll
                    for (int bj = 0; bj < 2; ++bj)
#pragma unroll
                        for (int n = 0; n < 2; ++n) *(f32x4*)(pp + bj * HALF + n * 16) = gv[bj][n] * acc[ai][bj][m][n]; }
        } else {
#pragma unroll
            for (int ai = 0; ai < 2; ++ai) { f32x4 xv[4][2][2];
#pragma unroll
                for (int m = 0; m < 4; ++m) { const float* rinp = Xin + (size_t)(row0 + ai * HALF + m * 16) * DM + col0;
#pragma unroll
                    for (int bj = 0; bj < 2; ++bj)
#pragma unroll
                        for (int n = 0; n < 2; ++n) xv[m][bj][n] = *(const f32x4*)(rinp + bj * HALF + n * 16); }
                asm volatile("" ::: "memory");
#pragma unroll
                for (int m = 0; m < 4; ++m) { float* rowp = X + (size_t)(row0 + ai * HALF + m * 16) * DM + col0;
#pragma unroll
                    for (int bj = 0; bj < 2; ++bj)
#pragma unroll
                        for (int n = 0; n < 2; ++n) *(f32x4*)(rowp + bj * HALF + n * 16) = xv[m][bj][n] + gv[bj][n] * acc[ai][bj][m][n]; }
                asm volatile("" ::: "memory"); }
        }
    }
};
template <int ACT> struct EpiBf16 {
    static constexpr bool PERM = true; bf16_t* O; int ldc;
    DEVI void operator()(const AccT& acc, const Unit& u, int wr, int wc, int fr, int fq) const {
        const int row0 = u.pm * BM + wr * 64 + fr, col0 = u.pn * BM + wc * 32 + 8 * fq;
#pragma unroll
        for (int ai = 0; ai < 2; ++ai)
#pragma unroll
            for (int m = 0; m < 4; ++m) { bf16_t* rowp = O + (size_t)(row0 + ai * HALF + m * 16) * ldc + col0;
#pragma unroll
                for (int bj = 0; bj < 2; ++bj) { f32x4 v0 = acc[ai][bj][m][0], v1 = acc[ai][bj][m][1];
                    if (ACT == 1) {
#pragma unroll
                        for (int j = 0; j < 4; ++j) { v0[j] = sigmoid_f(v0[j]); v1[j] = sigmoid_f(v1[j]); } }
                    u32x4 w; w.x = cvt_pk_bf16(v0[0], v0[1]); w.y = cvt_pk_bf16(v0[2], v0[3]); w.z = cvt_pk_bf16(v1[0], v1[1]); w.w = cvt_pk_bf16(v1[2], v1[3]);
                    *(u32x4*)(rowp + bj * HALF) = w; } }
    }
};
struct EpiGateA {
    static constexpr bool PERM = true; float* T1; const bf16_t* G;
    DEVI void operator()(const AccT& acc, const Unit& u, int wr, int wc, int fr, int fq) const {
        const int row0 = u.pm * BM + wr * 64 + fr, col0 = u.pn * BM + wc * 32 + 8 * fq;
#pragma unroll
        for (int ai = 0; ai < 2; ++ai) { u32x4 gw[4][2];
#pragma unroll
            for (int m = 0; m < 4; ++m) { const size_t row = (size_t)(row0 + ai * HALF + m * 16);
#pragma unroll
                for (int bj = 0; bj < 2; ++bj) gw[m][bj] = GCONST ? (u32x4){0x3f003f00u, 0x3f003f00u, 0x3f003f00u, 0x3f003f00u} : *(const u32x4*)(G + row * 2048 + col0 + bj * HALF); }
            asm volatile("" ::: "memory");
#pragma unroll
            for (int m = 0; m < 4; ++m) { const size_t row = (size_t)(row0 + ai * HALF + m * 16);
#pragma unroll
                for (int bj = 0; bj < 2; ++bj) { const u32x4 g4 = gw[m][bj]; float* tp = T1 + row * DM + col0 + bj * HALF;
                    *(f32x4*)tp = (f32x4){bflo(g4.x), bfhi(g4.x), bflo(g4.y), bfhi(g4.y)} * acc[ai][bj][m][0];
                    *(f32x4*)(tp + 4) = (f32x4){bflo(g4.z), bfhi(g4.z), bflo(g4.w), bfhi(g4.w)} * acc[ai][bj][m][1]; } }
            asm volatile("" ::: "memory"); }
    }
};
struct EpiGateB {
    static constexpr bool PERM = true; const float* T1; const bf16_t* G; bf16_t* Am;
    DEVI void operator()(const AccT& acc, const Unit& u, int wr, int wc, int fr, int fq) const {
        const int row0 = u.pm * BM + wr * 64 + fr, col0 = u.pn * BM + wc * 32 + 8 * fq;
#pragma unroll
        for (int ai = 0; ai < 2; ++ai)
#pragma unroll
            for (int mp = 0; mp < 2; ++mp) { u32x4 gw[2][2]; f32x4 tv[2][2][2];
#pragma unroll
                for (int mm = 0; mm < 2; ++mm) { const size_t row = (size_t)(row0 + ai * HALF + (mp * 2 + mm) * 16);
#pragma unroll
                    for (int bj = 0; bj < 2; ++bj) { const int c = col0 + bj * HALF; gw[mm][bj] = GCONST ? (u32x4){0x3f003f00u, 0x3f003f00u, 0x3f003f00u, 0x3f003f00u} : *(const u32x4*)(G + row * 2048 + 1024 + c);
                        tv[mm][bj][0] = *(const f32x4*)(T1 + row * DM + c); tv[mm][bj][1] = *(const f32x4*)(T1 + row * DM + c + 4); } }
                asm volatile("" ::: "memory");
#pragma unroll
                for (int mm = 0; mm < 2; ++mm) { const int m = mp * 2 + mm; const size_t row = (size_t)(row0 + ai * HALF + m * 16);
#pragma unroll
                    for (int bj = 0; bj < 2; ++bj) { const int c = col0 + bj * HALF; const u32x4 g4 = gw[mm][bj];
                        const f32x4 v0 = tv[mm][bj][0] + (f32x4){bflo(g4.x), bfhi(g4.x), bflo(g4.y), bfhi(g4.y)} * acc[ai][bj][m][0];
                        const f32x4 v1 = tv[mm][bj][1] + (f32x4){bflo(g4.z), bfhi(g4.z), bflo(g4.w), bfhi(g4.w)} * acc[ai][bj][m][1];
                        u32x4 w; w.x = cvt_pk_bf16(v0[0], v0[1]); w.y = cvt_pk_bf16(v0[2], v0[3]); w.z = cvt_pk_bf16(v1[0], v1[1]); w.w = cvt_pk_bf16(v1[2], v1[3]);
                        *(u32x4*)(Am + row * DM + c) = w; } }
                asm volatile("" ::: "memory"); }
    }
};

template <class Epi> DEVI void run_gemm(unsigned char* shm, const bf16_t* A, const bf16_t* Bt, int M, int N, int K, const Epi& E, bool rev = false) {
    Gemm g; g.A = A; g.Bt = Bt; g.M = M; g.N = N; g.K = K;
    StaticOrder S; S.init(M, N, K, (int)gridDim.x, rev ? (int)(gridDim.x - 1 - blockIdx.x) : (int)blockIdx.x);
    pg8::gemm_phase<Epi, StaticOrder>((LAS unsigned char*)shm, g, S, E);
}
template <class Epi> DEVI void run_gemm_split(unsigned char* shm, const bf16_t* A, const bf16_t* Bt, int Mfull, int Mtot, int N, int K, const Epi& E) {
    Gemm g; g.A = A; g.Bt = Bt; g.M = Mtot; g.N = N; g.K = K;
    pg8::SplitOrder S; S.init(Mfull, Mtot, N, K, (int)gridDim.x, (int)blockIdx.x);
    pg8::gemm_phase<Epi, pg8::SplitOrder>((LAS unsigned char*)shm, g, S, E);
}

DEVI float shx(float v, int lane, int m) { return __int_as_float(__builtin_amdgcn_ds_bpermute((lane ^ m) << 2, __float_as_int(v))); }
DEVI float wave_sum(float v, int lane) {
#pragma unroll
    for (int o = 32; o >= 1; o >>= 1) v += shx(v, lane, o);
    return v;
}

DEVI void norm_phase(float* X, bf16_t* Hn, const float* g, const float* modl, int ish, int isc, int M, const float* part, int nsl, const float* xlat = nullptr) {
    const int tid_ = otid(), lane = tid_ & 63, wid = tid_ >> 6;
    f32x4 gg[4];
#pragma unroll
    for (int i = 0; i < 4; ++i) gg[i] = *(const f32x4*)(g + i * 256 + lane * 4);
    for (int row = blockIdx.x * 8 + wid; row < M; row += gridDim.x * 8) {
        float* xr = X + (size_t)row * DM; const float* xs = (xlat && row < MLAT) ? xlat + (size_t)row * DM : xr; f32x4 v[4], sh[4], sc[4]; float ss = 0.f;
        const int brow = row < MLAT ? (row >> 12) : 4; const float* mb = modl + brow * 9216;
#pragma unroll
        for (int i = 0; i < 4; ++i) { v[i] = *(const f32x4*)(xs + i * 256 + lane * 4); sh[i] = *(const f32x4*)(mb + ish * 1024 + i * 256 + lane * 4); sc[i] = *(const f32x4*)(mb + isc * 1024 + i * 256 + lane * 4); }
        if (row >= MLAT && nsl > 0) {
            for (int s0 = 0; s0 < nsl; s0 += 4) {
                f32x4 t[4][4];
#pragma unroll
                for (int q = 0; q < 4; ++q) { const int sl = s0 + q < nsl ? s0 + q : nsl - 1; const float* pr = part + ((size_t)sl * 1024 + (row - MLAT)) * DM;
#pragma unroll
                    for (int i = 0; i < 4; ++i) t[q][i] = *(const f32x4*)(pr + i * 256 + lane * 4); }
                asm volatile("" ::: "memory");
#pragma unroll
                for (int q = 0; q < 4; ++q) if (s0 + q < nsl) {
#pragma unroll
                    for (int i = 0; i < 4; ++i) v[i] += t[q][i]; } }
#pragma unroll
            for (int i = 0; i < 4; ++i) *(f32x4*)(xr + i * 256 + lane * 4) = v[i];
        }
#pragma unroll
        for (int i = 0; i < 4; ++i) ss += v[i][0] * v[i][0] + v[i][1] * v[i][1] + v[i][2] * v[i][2] + v[i][3] * v[i][3];
        ss = wave_sum(ss, lane); const float rstd = rsqrtf(ss * (1.f / 1024.f) + 1e-6f);
#pragma unroll
        for (int i = 0; i < 4; ++i) { const int c = i * 256 + lane * 4;
            const f32x4 h = (v[i] * rstd * gg[i]) * (sc[i] + 1.f) + sh[i]; u32x2 w; w.x = cvt_pk_bf16(h[0], h[1]); w.y = cvt_pk_bf16(h[2], h[3]); *(u32x2*)(Hn + (size_t)row * DM + c) = w; }
    }
}
DEVI void final_norm_phase(const float* X, float* out, const float* g) {
    const int tid_ = otid(), lane = tid_ & 63, wid = tid_ >> 6;
    f32x4 gg[4];
#pragma unroll
    for (int i = 0; i < 4; ++i) gg[i] = *(const f32x4*)(g + i * 256 + lane * 4);
    for (int row = blockIdx.x * 8 + wid; row < MLAT; row += gridDim.x * 8) {
        const float* xr = X + (size_t)row * DM; f32x4 v[4]; float ss = 0.f;
#pragma unroll
        for (int i = 0; i < 4; ++i) { v[i] = *(const f32x4*)(xr + i * 256 + lane * 4); ss += v[i][0] * v[i][0] + v[i][1] * v[i][1] + v[i][2] * v[i][2] + v[i][3] * v[i][3]; }
        ss = wave_sum(ss, lane); const float rstd = rsqrtf(ss * (1.f / 1024.f) + 1e-6f);
#pragma unroll
        for (int i = 0; i < 4; ++i) { const int c = i * 256 + lane * 4; *(f32x4*)(out + (size_t)row * DM + c) = v[i] * rstd * gg[i]; }
    }
}

DEVI void xinit_phase(const Params& p, float* X) {
    const size_t n4b = (size_t)1024 * DM / 4;
    const f32x4* cs = (const f32x4*)p.in[2]; f32x4* xd = (f32x4*)(X + (size_t)MLAT * DM);
    const int tid_ = otid();
    for (size_t i = (size_t)blockIdx.x * 512 + tid_; i < n4b; i += (size_t)gridDim.x * 512) xd[i] = cs[i];
}
DEVI void mod_phase(const Params& p, float* MOD, unsigned char* shm) {
    float* s = (float*)shm;
    float* red = (float*)(shm + 20480);
    const int tid = otid();
    { float cv[10];
#pragma unroll
      for (int q = 0; q < 8; ++q) cv[q] = p.in[1][tid + 512 * q];
#pragma unroll
      for (int q = 0; q < 2; ++q) cv[8 + q] = p.in[3][tid + 512 * q];
#pragma unroll
      for (int q = 0; q < 10; ++q) s[tid + 512 * q] = silu_f(cv[q]); }
    __syncthreads();
    for (int job = blockIdx.x; job < 288; job += gridDim.x) {
        const int layer = job / 144, col0 = (job % 144) * 64;
        const int kg = tid >> 6, cl = tid & 63; const float* w = p.in[4] + (size_t)layer * 1024 * 9216 + col0 + cl;
        float a0 = 0.f, a1 = 0.f, a2 = 0.f, a3 = 0.f, a4 = 0.f;
#pragma unroll 16
        for (int k = kg * 128; k < kg * 128 + 128; ++k) { const float wv = w[(size_t)k * 9216]; a0 += s[k] * wv; a1 += s[1024 + k] * wv; a2 += s[2048 + k] * wv; a3 += s[3072 + k] * wv; a4 += s[4096 + k] * wv; }
        red[(kg * 5 + 0) * 64 + cl] = a0; red[(kg * 5 + 1) * 64 + cl] = a1; red[(kg * 5 + 2) * 64 + cl] = a2; red[(kg * 5 + 3) * 64 + cl] = a3; red[(kg * 5 + 4) * 64 + cl] = a4;
        __syncthreads();
        if (tid < 320) { const int r = tid >> 6; float t = p.in[5][layer * 9216 + col0 + cl];
            for (int q = 0; q < 8; ++q) t += red[(q * 5 + r) * 64 + cl];
            MOD[(layer * 5 + r) * 9216 + col0 + cl] = t; }
        __syncthreads();
    }
}
DEVI void h2_phase(const Params& p, float* H2, unsigned char* shm) {
    const int tid = otid(), lane = tid & 63, wid = tid >> 6;
    float* zb = (float*)shm + wid * 128; float* hb = zb + 64;
    for (int job = (blockIdx.x + 64) % gridDim.x; job < 1088; job += gridDim.x) {
        const int layer = job / 544, rem = (job % 544) * 8 + wid;
        const int L = rem < 4096 ? 4096 : 256, t = rem < 4096 ? rem : rem - 4096;
        const float wv = (6.283185307179586f / (float)L) * (float)t;
        if (lane < 33) { float z;
            if (lane == 0) z = (float)t / (float)(L - 1);
            else { const int i = (lane - 1) & 15; const float f = 1e-4f + (float)i * ((15.f - 1e-4f) / 15.f); const float a = f * wv; z = lane <= 16 ? cosf(a) : -sinf(a); }
            zb[lane] = z; }
        __syncthreads();
        const float* w1 = p.in[20] + layer * 33 * 64; float a = p.in[21][layer * 64 + lane];
        for (int e = 0; e < 33; ++e) a += zb[e] * w1[e * 64 + lane];
        hb[lane] = sinf(p.in[22][layer * 64 + lane] * a);
        __syncthreads();
        const float* w2 = p.in[23] + layer * 64 * 64; float b = p.in[24][layer * 64 + lane];
        for (int e = 0; e < 64; ++e) b += hb[e] * w2[e * 64 + lane];
        H2[((size_t)layer * 4352 + rem) * 64 + lane] = sinf(p.in[25][layer * 64 + lane] * b);
        __syncthreads();
    }
}
DEVI int win_src(int row) {
    if (row < 1536) return row;
    if (row < 2048) return 1568 + (row - 1536);
    if (row < 3072) return 2080 + (row - 2048);
    if (row < 3104) return 1536 + (row - 3072);
    if (row < 3328) return -1;
    if (row < 6400) return 3104 + (row - 3328);
    return 6176 + (row - 6400);
}
DEVI void convert_phase(const Params& p, int layer, unsigned char* W, unsigned char* shm) {
    float* tile = (float*)shm;
    const int tid = otid();
    for (int job = (blockIdx.x + 240) % gridDim.x; job < 1776; job += gridDim.x) {
        int m, tr, tk, K; bf16_t* dst;
        if (job < 352) { m = 0; tr = job >> 2; tk = job & 3; K = 1024; dst = (bf16_t*)(W + W_GU1); }
        else if (job < 528) { const int j = job - 352; m = 1; tr = j / 11; tk = j % 11; K = 2816; dst = (bf16_t*)(W + W_D1); }
        else if (job < 1056) { const int j = job - 528; m = 2; tr = j >> 2; tk = j & 3; K = 1024; dst = (bf16_t*)(W + W_IN); }
        else if (job < 1248) { const int j = job - 1056; m = 3 + (j >> 6); tr = (j & 63) >> 2; tk = j & 3; K = 1024; dst = (bf16_t*)(W + W_GO + (size_t)(m - 3) * 2097152); }
        else if (job < 1600) { const int j = job - 1248; m = 6; tr = j >> 2; tk = j & 3; K = 1024; dst = (bf16_t*)(W + W_GU2); }
        else { const int j = job - 1600; m = 7; tr = j / 11; tk = j % 11; K = 2816; dst = (bf16_t*)(W + W_D2); }
        const int r0 = tr * 64, k0 = tk * 256, nn = tid & 63, kk = tid >> 6, row = r0 + nn;
        const float* src; size_t ld; int sc;
        switch (m) {
            case 0: src = (((row >> 7) & 1) ? p.in[8] : p.in[7]) + (size_t)layer * 1024 * DFF; ld = DFF; sc = (row >> 8) * 128 + (row & 127); break;
            case 1: src = p.in[9] + (size_t)layer * DFF * 1024; ld = 1024; sc = row; break;
            case 2: src = p.in[11] + (size_t)layer * 1024 * INW; ld = INW; sc = win_src(row); break;
            case 3: src = p.in[17] + (size_t)layer * 1024 * 1024; ld = 1024; sc = row; break;
            case 4: src = p.in[28] + (size_t)layer * 1024 * 1024; ld = 1024; sc = row; break;
            case 5: src = p.in[29] + (size_t)layer * 1024 * 1024; ld = 1024; sc = row; break;
            case 6: src = (((row >> 7) & 1) ? p.in[32] : p.in[31]) + (size_t)layer * 1024 * DFF; ld = DFF; sc = (row >> 8) * 128 + (row & 127); break;
            default: src = p.in[33] + (size_t)layer * DFF * 1024; ld = 1024; sc = row; break;
        }
        { const float* sp = src + (size_t)(k0 + kk) * ld + (sc >= 0 ? sc : 0); float v[32];
#pragma unroll
          for (int i = 0; i < 32; ++i) v[i] = sp[(size_t)(8 * i) * ld];
#pragma unroll
          for (int i = 0; i < 32; ++i) tile[(kk + 8 * i) * 65 + nn] = sc >= 0 ? v[i] : 0.f; }
        __syncthreads();
        { const int n2 = tid >> 3, kq = tid & 7;
#pragma unroll
          for (int kb = 0; kb < 4; ++kb) { float v[8];
#pragma unroll
              for (int i = 0; i < 8; ++i) v[i] = tile[(kb * 64 + kq * 8 + i) * 65 + n2];
              *(u32x4*)(dst + (size_t)(r0 + n2) * K + k0 + kb * 64 + kq * 8) = pack8(v); } }
        __syncthreads();
    }
}

DEVI void gla_prep_phase(const Params& p, int layer, int vc, bf16_t* Pg, bf16_t* QF, bf16_t* KF, float* DEC, bf16_t* ATTf, bf16_t* ATTb, unsigned char* smem) {
    const int tid = otid(), lane = tid & 63, wid = tid >> 6, lr = lane & 15, lq = lane >> 4;
    float* sB = (float*)smem;
    const int r = tid >> 3, seg = tid & 7, d0 = wid * 16;
    const int njobs = vc >= 0 ? 136 : 1088, jstart = vc >= 0 ? (vc >> 3) : (int)blockIdx.x, jstep = vc >= 0 ? 32 : (int)gridDim.x;
    for (int job = jstart; job < njobs; job += jstep) {
        int cgi, h;
        if (vc >= 0) { const int xb_ = (vc & 7) >> 1, ci = job >> 1; h = 2 * (vc & 1) + (job & 1); cgi = ci < 64 ? xb_ * 64 + ci : 256 + xb_ * 4 + (ci - 64); }
        else { cgi = job >> 2; h = job & 3; }
        const int base = cgi * 64;
        const bf16_t* rowp = Pg + (size_t)(base + r) * PGW;
        const u32x4 q0 = *(const u32x4*)(rowp + 1536 + h * 128 + seg * 8), q1 = *(const u32x4*)(rowp + 1536 + h * 128 + 64 + seg * 8);
        const u32x4 k0 = *(const u32x4*)(rowp + h * 128 + seg * 8), k1 = *(const u32x4*)(rowp + h * 128 + 64 + seg * 8);
#pragma unroll
        for (int dir = 0; dir < 2; ++dir) {
            const float* wa = (dir ? p.in[14] : p.in[12]) + layer * 16 * 512; const float* ba = (dir ? p.in[15] : p.in[13]) + layer * 512;
            bf16x8 bwa; { float t[8];
#pragma unroll
                for (int i = 0; i < 8; ++i) t[i] = wa[((lq & 1) * 8 + i) * 512 + h * 128 + d0 + lr];
#pragma unroll
                for (int i = 0; i < 8; ++i) t[i] = lq < 2 ? t[i] : 0.f;
                bwa = __builtin_bit_cast(bf16x8, pack8(t)); }
            const float ba_d = ba[h * 128 + d0 + lr];
            const int acol = 3072 + dir * 16;
            float off = 0.f; float bv[4][4];
#pragma unroll
            for (int rt = 0; rt < 4; ++rt) { const int rr = rt * 16 + lr; const u32x4 fa = *(const u32x4*)(Pg + (size_t)(base + (dir ? 63 - rr : rr)) * PGW + acol + (lq & 1) * 8);
                const bf16x8 af = lq < 2 ? __builtin_bit_cast(bf16x8, fa) : (bf16x8){0, 0, 0, 0, 0, 0, 0, 0};
                const f32x4 x = __builtin_amdgcn_mfma_f32_16x16x32_bf16(af, bwa, (f32x4){0.f, 0.f, 0.f, 0.f}, 0, 0, 0);
                float run = 0.f;
#pragma unroll
                for (int g = 0; g < 4; ++g) { const float xv = x[g] + ba_d; run += (fminf(xv, 0.f) - __logf(1.f + __expf(-fabsf(xv)))) * 0.0625f; bv[rt][g] = run; }
                float inc = run;
                float u = __int_as_float(__builtin_amdgcn_ds_bpermute((lane - 16) << 2, __float_as_int(inc))); if (lq >= 1) inc += u;
                u = __int_as_float(__builtin_amdgcn_ds_bpermute((lane - 32) << 2, __float_as_int(inc))); if (lq >= 2) inc += u;
                const float tot = __int_as_float(__builtin_amdgcn_ds_bpermute((48 + lr) << 2, __float_as_int(inc)));
                const float bs = off + (inc - run); off += tot;
#pragma unroll
                for (int g = 0; g < 4; ++g) sB[(dir * 64 + rt * 16 + lq * 4 + g) * 132 + d0 + lr] = bs + bv[rt][g]; }
            if (lq == 0) DEC[((size_t)dir * 272 + cgi) * 512 + h * 128 + d0 + lr] = __expf(off);
        }
        __syncthreads();
        { float qf[16], kf[16]; unpack8(q0, qf); unpack8(q1, qf + 8); unpack8(k0, kf); unpack8(k1, kf + 8);
          const size_t tok = (size_t)(base + r);
#pragma unroll
          for (int dir = 0; dir < 2; ++dir) {
              bf16_t* qdst = dir ? Pg + tok * PGW + 1536 + h * 128 : QF + tok * 512 + h * 128;
              bf16_t* kdst = dir ? Pg + tok * PGW + h * 128 : KF + tok * 512 + h * 128;
              const float* sb = sB + (dir * 64 + (dir ? 63 - r : r)) * 132;
#pragma unroll
              for (int hh = 0; hh < 2; ++hh) { const int db = hh * 64 + seg * 8; float qd[8], kn[8];
                  const f32x4 b0 = *(const f32x4*)(sb + db), b1 = *(const f32x4*)(sb + db + 4);
#pragma unroll
                  for (int e = 0; e < 8; ++e) { const float bb = e < 4 ? b0[e & 3] : b1[e & 3]; const float eb = __expf(bb), enb = __builtin_amdgcn_rcpf(eb);
                      qd[e] = qf[hh * 8 + e] * 0.08838834764831845f * eb; kn[e] = kf[hh * 8 + e] * enb; }
                  const u32x4 qw = pack8(qd), kw = pack8(kn);
                  *(u32x4*)(qdst + db) = qw; *(u32x4*)(kdst + db) = kw;
                  bf16_t* tq_ = (bf16_t*)(smem + 67584 + dir * 34816) + (dir ? 63 - r : r) * 136 + db;
                  *(u32x4*)tq_ = qw; *(u32x4*)(tq_ + 8704) = kw; } } }
        __syncthreads();
        { const int dir = wid >> 2, ib = wid & 3, i0 = ib * 16;
          const bf16_t* Qd = (const bf16_t*)(smem + 67584 + dir * 34816); const bf16_t* Kd = Qd + 8704;
          bf16_t* dst = (dir ? ATTb : ATTf) + ((size_t)(cgi * 4 + h)) * 4096 + (i0 + lr) * 64 + lq * 4;
          bf16x8 qfr[4];
#pragma unroll
          for (int ks = 0; ks < 4; ++ks) qfr[ks] = *(const bf16x8*)(Qd + (i0 + lr) * 136 + ks * 32 + lq * 8);
#pragma unroll
          for (int jb = 0; jb < 4; ++jb) { f32x4 a = (f32x4){0.f, 0.f, 0.f, 0.f};
              if (jb <= ib) {
#pragma unroll
                  for (int ks = 0; ks < 4; ++ks) { const bf16x8 kfr = *(const bf16x8*)(Kd + (jb * 16 + lr) * 136 + ks * 32 + lq * 8); a = __builtin_amdgcn_mfma_f32_16x16x32_bf16(kfr, qfr[ks], a, 0, 0, 0); } }
              const int i = i0 + lr, j0 = jb * 16 + lq * 4;
              u32x2 w; w.x = cvt_pk_bf16(j0 <= i ? a[0] : 0.f, j0 + 1 <= i ? a[1] : 0.f); w.y = cvt_pk_bf16(j0 + 2 <= i ? a[2] : 0.f, j0 + 3 <= i ? a[3] : 0.f);
              *(u32x2*)(dst + jb * 16) = w; } }
        __syncthreads();
    }
}

DEVI bf16x8 tr_frag(unsigned a0, unsigned a1) {
    u32x2 lo, hi;
    asm volatile("ds_read_b64_tr_b16 %0, %2\n\tds_read_b64_tr_b16 %1, %3\n\ts_waitcnt lgkmcnt(0)" : "=&v"(lo), "=&v"(hi) : "v"(a0), "v"(a1) : "memory");
    return __builtin_bit_cast(bf16x8, (u32x4){lo.x, lo.y, hi.x, hi.y});
}
DEVI void tr_frag2(unsigned a0, unsigned d0, unsigned a1, unsigned d1, bf16x8& f0, bf16x8& f1) {
    u32x2 l0, h0, l1, h1;
    asm volatile("ds_read_b64_tr_b16 %0, %4\n\tds_read_b64_tr_b16 %1, %5\n\tds_read_b64_tr_b16 %2, %6\n\tds_read_b64_tr_b16 %3, %7\n\ts_waitcnt lgkmcnt(0)"
                 : "=&v"(l0), "=&v"(h0), "=&v"(l1), "=&v"(h1) : "v"(a0), "v"(a0 + d0), "v"(a1), "v"(a1 + d1) : "memory");
    f0 = __builtin_bit_cast(bf16x8, (u32x4){l0.x, l0.y, h0.x, h0.y}); f1 = __builtin_bit_cast(bf16x8, (u32x4){l1.x, l1.y, h1.x, h1.y});
}
DEVI void tr_frag4(unsigned a0, unsigned a1, unsigned da, unsigned b0, unsigned b1, unsigned db, bf16x8& fa0, bf16x8& fa1, bf16x8& fb0, bf16x8& fb1) {
    u32x2 l0, h0, l1, h1, l2, h2, l3, h3;
    asm volatile("ds_read_b64_tr_b16 %0, %8\n\tds_read_b64_tr_b16 %1, %9\n\tds_read_b64_tr_b16 %2, %10\n\tds_read_b64_tr_b16 %3, %11\n\t"
                 "ds_read_b64_tr_b16 %4, %12\n\tds_read_b64_tr_b16 %5, %13\n\tds_read_b64_tr_b16 %6, %14\n\tds_read_b64_tr_b16 %7, %15\n\ts_waitcnt lgkmcnt(0)"
                 : "=&v"(l0), "=&v"(h0), "=&v"(l1), "=&v"(h1), "=&v"(l2), "=&v"(h2), "=&v"(l3), "=&v"(h3)
                 : "v"(a0), "v"(a0 + da), "v"(a1), "v"(a1 + da), "v"(b0), "v"(b0 + db), "v"(b1), "v"(b1 + db) : "memory");
    fa0 = __builtin_bit_cast(bf16x8, (u32x4){l0.x, l0.y, h0.x, h0.y}); fa1 = __builtin_bit_cast(bf16x8, (u32x4){l1.x, l1.y, h1.x, h1.y});
    fb0 = __builtin_bit_cast(bf16x8, (u32x4){l2.x, l2.y, h2.x, h2.y}); fb1 = __builtin_bit_cast(bf16x8, (u32x4){l3.x, l3.y, h3.x, h3.y});
}
DEVI void tr_frag3(unsigned a0, unsigned a1, unsigned da, unsigned b0, unsigned db, bf16x8& f0, bf16x8& f1, bf16x8& f2) {
    u32x2 l0, h0, l1, h1, l2, h2;
    asm volatile("ds_read_b64_tr_b16 %0, %6\n\tds_read_b64_tr_b16 %1, %7\n\tds_read_b64_tr_b16 %2, %8\n\tds_read_b64_tr_b16 %3, %9\n\t"
                 "ds_read_b64_tr_b16 %4, %10\n\tds_read_b64_tr_b16 %5, %11\n\ts_waitcnt lgkmcnt(0)"
                 : "=&v"(l0), "=&v"(h0), "=&v"(l1), "=&v"(h1), "=&v"(l2), "=&v"(h2)
                 : "v"(a0), "v"(a0 + da), "v"(a1), "v"(a1 + da), "v"(b0), "v"(b0 + db) : "memory");
    f0 = __builtin_bit_cast(bf16x8, (u32x4){l0.x, l0.y, h0.x, h0.y}); f1 = __builtin_bit_cast(bf16x8, (u32x4){l1.x, l1.y, h1.x, h1.y}); f2 = __builtin_bit_cast(bf16x8, (u32x4){l2.x, l2.y, h2.x, h2.y});
}
DEVI void gla_phase(const Params& p, int layer, int vc, const bf16_t* Pg, const bf16_t* QF, const bf16_t* KF, const float* DEC, const bf16_t* ATTf, const bf16_t* ATTb, bf16_t* Of, bf16_t* Ob, unsigned char* smem) {
    const int tid = otid(), lane = tid & 63, wid = tid >> 6, lr = lane & 15, lq = lane >> 4;
    constexpr int BUF = 49664;
    bf16_t* sST = (bf16_t*)(smem + 2 * BUF);
    const unsigned lds0 = (unsigned)(size_t)smem;
    const int r = tid >> 3, seg = tid & 7, r2 = (tid >> 2) & 63, sg = tid & 3;
    const int tq = (lane & 15) >> 2, tp = lane & 3;
    const int jstart = vc >= 0 ? (((vc & 7) * 4 + (vc >> 6)) * 8 + ((vc >> 3) & 7)) : (int)blockIdx.x, jstep = vc >= 0 ? 256 : (int)gridDim.x;
    for (int job = jstart; job < 256; job += jstep) {
        const int sl = job & 7, grp = job >> 3, dir = grp & 1, h = (grp >> 1) & 3, b = grp >> 3;
        for (int i = tid; i < 2 * 32 * 136 / 2; i += 512) ((unsigned*)sST)[i] = 0u;
        f32x4 S[2];
        S[0] = (f32x4){0.f, 0.f, 0.f, 0.f}; S[1] = (f32x4){0.f, 0.f, 0.f, 0.f};
        bf16_t* O = dir ? Ob : Of; const bf16_t* ATTd = dir ? ATTb : ATTf;
        const int vcol = 512 + h * 256 + sl * 32 + sg * 8;
        u32x4 qa0, qa1, ka0, ka1, va, ata, qb0, qb1, kb0, kb1, vb, atb; f32x4 dca, dcb;
#define GLA_BASE(s_) ((s_) < 4 ? MLAT + b * 256 + (dir ? 3 - (s_) : (s_)) * 64 : b * 4096 + (dir ? 63 - ((s_) - 4) : ((s_) - 4)) * 64)
#define GLA_LOAD(s_, q0, q1, k0, k1, vr, at, dc) do { const int base_ = GLA_BASE(s_); const size_t tok_ = (size_t)(base_ + (dir ? 63 - r : r)); \
            const bf16_t* qp_ = dir ? Pg + tok_ * PGW + 1536 + h * 128 + seg * 8 : QF + tok_ * 512 + h * 128 + seg * 8; \
            const bf16_t* kp_ = dir ? Pg + tok_ * PGW + h * 128 + seg * 8 : KF + tok_ * 512 + h * 128 + seg * 8; \
            q0 = *(const u32x4*)qp_; q1 = *(const u32x4*)(qp_ + 64); k0 = *(const u32x4*)kp_; k1 = *(const u32x4*)(kp_ + 64); \
            vr = *(const u32x4*)(Pg + (size_t)(base_ + (dir ? 63 - r2 : r2)) * PGW + vcol); \
            at = *(const u32x4*)(ATTd + ((size_t)((base_ >> 6) * 4 + h)) * 4096 + tid * 8); \
            dc = *(const f32x4*)(DEC + ((size_t)dir * 272 + (base_ >> 6)) * 512 + h * 128 + (tid & 31) * 4); } while (0)
#define GLA_FILL(bf_, q0, q1, k0, k1, vr, at, dc) do { unsigned char* bb_ = smem + (bf_) * BUF; bf16_t* sQ_ = (bf16_t*)bb_; bf16_t* sK_ = (bf16_t*)(bb_ + 17408); bf16_t* sV_ = (bf16_t*)(bb_ + 34816); \
            *(u32x4*)(sQ_ + r * 136 + seg * 8) = q0; *(u32x4*)(sQ_ + r * 136 + 64 + seg * 8) = q1; *(u32x4*)(sK_ + r * 136 + seg * 8) = k0; *(u32x4*)(sK_ + r * 136 + 64 + seg * 8) = k1; \
            *(u32x4*)((bf16_t*)(bb_ + 40448) + r * 72 + seg * 8) = at; \
            if (tid < 256) *(u32x4*)(sV_ + r2 * 40 + sg * 8) = vr; if (tid < 32) *(f32x4*)(bb_ + 39936 + tid * 16) = dc; } while (0)
        GLA_LOAD(0, qa0, qa1, ka0, ka1, va, ata, dca); GLA_LOAD(1, qb0, qb1, kb0, kb1, vb, atb, dcb);
        GLA_FILL(0, qa0, qa1, ka0, ka1, va, ata, dca);
        GLA_LOAD(2, qa0, qa1, ka0, ka1, va, ata, dca);
        __syncthreads();
        auto step = [&](const int s, u32x4& q0, u32x4& q1, u32x4& k0, u32x4& k1, u32x4& vr, u32x4& at, f32x4& dcn) __attribute__((always_inline)) {
            const int base = GLA_BASE(s);
            const int cur = s & 1, nx = cur ^ 1;
            const bf16_t* sQ = (const bf16_t*)(smem + cur * BUF); const bf16_t* sAtt = (const bf16_t*)(smem + cur * BUF + 40448);
            const unsigned aK = lds0 + cur * BUF + 17408, aV = lds0 + cur * BUF + 34816;
            { bf16x8 v0[2], v1[2], kt[2];
#pragma unroll
              for (int ks = 0; ks < 2; ++ks) { const int row0 = ks * 32 + lq * 8 + tq; const unsigned av = aV + row0 * 80 + tp * 8, ak = aK + row0 * 272 + (wid * 16 + tp * 4) * 2;
                  tr_frag3(av, av + 32, 4 * 80, ak, 4 * 272, v0[ks], v1[ks], kt[ks]); }
#pragma unroll
              for (int ks = 0; ks < 2; ++ks) { S[0] = __builtin_amdgcn_mfma_f32_16x16x32_bf16(kt[ks], v0[ks], S[0], 0, 0, 0); S[1] = __builtin_amdgcn_mfma_f32_16x16x32_bf16(kt[ks], v1[ks], S[1], 0, 0, 0); }
              const f32x4 dec = *(const f32x4*)(smem + cur * BUF + 39936 + (wid * 16 + lq * 4) * 4);
#pragma unroll
              for (int cb = 0; cb < 2; ++cb) { S[cb] *= dec; u32x2 w; w.x = cvt_pk_bf16(S[cb][0], S[cb][1]); w.y = cvt_pk_bf16(S[cb][2], S[cb][3]);
                  *(u32x2*)(sST + nx * 4352 + (cb * 16 + lr) * 136 + wid * 16 + lq * 4) = w; } }
            { const int i0 = (wid & 3) * 16, dvb = wid >> 2; f32x4 a = (f32x4){0.f, 0.f, 0.f, 0.f}, a2 = (f32x4){0.f, 0.f, 0.f, 0.f};
              bf16x8 sf[4], qf[4], af[2], vt[2];
#pragma unroll
              for (int ks = 0; ks < 4; ++ks) { sf[ks] = *(const bf16x8*)(sST + cur * 4352 + (dvb * 16 + lr) * 136 + ks * 32 + lq * 8); qf[ks] = *(const bf16x8*)(sQ + (i0 + lr) * 136 + ks * 32 + lq * 8); }
#pragma unroll
              for (int ks = 0; ks < 2; ++ks) af[ks] = *(const bf16x8*)(sAtt + (i0 + lr) * 72 + ks * 32 + lq * 8);
              { const unsigned av = aV + (lq * 8 + tq) * 80 + (dvb * 16 + tp * 4) * 2; tr_frag2(av, 4 * 80, av + 32 * 80, 4 * 80, vt[0], vt[1]); }
              a = __builtin_amdgcn_mfma_f32_16x16x32_bf16(sf[0], qf[0], a, 0, 0, 0); a2 = __builtin_amdgcn_mfma_f32_16x16x32_bf16(vt[0], af[0], a2, 0, 0, 0);
              a = __builtin_amdgcn_mfma_f32_16x16x32_bf16(sf[1], qf[1], a, 0, 0, 0); a2 = __builtin_amdgcn_mfma_f32_16x16x32_bf16(vt[1], af[1], a2, 0, 0, 0);
              a = __builtin_amdgcn_mfma_f32_16x16x32_bf16(sf[2], qf[2], a, 0, 0, 0); a2 = __builtin_amdgcn_mfma_f32_16x16x32_bf16(sf[3], qf[3], a2, 0, 0, 0);
              a += a2;
              const int i = i0 + lr; u32x2 w; w.x = cvt_pk_bf16(a[0], a[1]); w.y = cvt_pk_bf16(a[2], a[3]);
              *(u32x2*)(O + (size_t)(base + (dir ? 63 - i : i)) * DM + h * 256 + sl * 32 + dvb * 16 + lq * 4) = w; }
            GLA_FILL(nx, q0, q1, k0, k1, vr, at, dcn); { const int s3 = s + 3 < 68 ? s + 3 : 67; GLA_LOAD(s3, q0, q1, k0, k1, vr, at, dcn); }
            __syncthreads();
        };
#pragma unroll 1
        for (int s = 0; s < 68; s += 2) { step(s, qb0, qb1, kb0, kb1, vb, atb, dcb); step(s + 1, qa0, qa1, ka0, ka1, va, ata, dca); }
#undef GLA_BASE
#undef GLA_LOAD
#undef GLA_FILL
    }
}

DEVI void gla_post_phase(const Params& p, int layer, const bf16_t* Pg, bf16_t* Of, const bf16_t* Ob, int M) {
    const int tid_ = otid(), lane = tid_ & 63, wid = tid_ >> 6;
    float gn[16]; { const f32x4* gp = (const f32x4*)(p.in[16] + layer * 1024 + lane * 16);
#pragma unroll
      for (int i = 0; i < 4; ++i) { const f32x4 t = gp[i]; gn[i * 4] = t[0]; gn[i * 4 + 1] = t[1]; gn[i * 4 + 2] = t[2]; gn[i * 4 + 3] = t[3]; } }
    for (int row = blockIdx.x * 8 + wid; row < M; row += gridDim.x * 8) {
        float of[16], ob[16], rr[16];
        bf16_t* op = Of + (size_t)row * DM + lane * 16; const bf16_t* bp = Ob + (size_t)row * DM + lane * 16; const bf16_t* rp = Pg + (size_t)row * PGW + 2048 + lane * 16;
        unpack8(*(const u32x4*)op, of); unpack8(*(const u32x4*)(op + 8), of + 8); unpack8(*(const u32x4*)bp, ob); unpack8(*(const u32x4*)(bp + 8), ob + 8);
        unpack8(*(const u32x4*)rp, rr); unpack8(*(const u32x4*)(rp + 8), rr + 8);
        float ss = 0.f;
#pragma unroll
        for (int i = 0; i < 16; ++i) { of[i] += ob[i]; ss += of[i] * of[i]; }
        ss += shx(ss, lane, 1); ss += shx(ss, lane, 2); ss += shx(ss, lane, 4); ss += shx(ss, lane, 8);
        const float rstd = rsqrtf(ss * (1.f / 256.f) + 1e-6f);
#pragma unroll
        for (int i = 0; i < 16; ++i) of[i] = of[i] * rstd * gn[i] * silu_f(rr[i]);
        *(u32x4*)op = pack8(of); *(u32x4*)(op + 8) = pack8(of + 8);
    }
}

DEVI void transpose_phase(const bf16_t* Z, bf16_t* Ah, int M, unsigned char* shm) {
    bf16_t* tile = (bf16_t*)shm;
    const int tid = otid(), ntt = M / 64, njobs = 16 * ntt;
    const int cr = tid >> 3, sg = tid & 7;
    int job = blockIdx.x;
    u32x4 cur = (u32x4){0u, 0u, 0u, 0u};
    if (job < njobs) cur = *(const u32x4*)(Z + (size_t)((job % 16) * 64 + cr) * MTOT + (job / 16) * 64 + sg * 8);
    int par = 0;
    for (; job < njobs; job += gridDim.x) {
        const int c0 = (job % 16) * 64, t0 = (job / 16) * 64;
        const int nj = job + (int)gridDim.x < njobs ? job + (int)gridDim.x : job;
        const u32x4 nxt = *(const u32x4*)(Z + (size_t)((nj % 16) * 64 + cr) * MTOT + (nj / 16) * 64 + sg * 8);
        bf16_t* tl = tile + par * (64 * 72);
        *(u32x4*)(tl + cr * 72 + sg * 8) = cur;
        __syncthreads();
        { const int tr = cr; unsigned w[4];
#pragma unroll
          for (int e = 0; e < 4; ++e) w[e] = (unsigned)tl[(sg * 8 + 2 * e) * 72 + tr] | ((unsigned)tl[(sg * 8 + 2 * e + 1) * 72 + tr] << 16);
          *(u32x4*)(Ah + (size_t)(t0 + tr) * DM + c0 + sg * 8) = (u32x4){w[0], w[1], w[2], w[3]}; }
        cur = nxt; par ^= 1;
    }
    __syncthreads();
}

DEVI float hy_delta(int c) { const float mn = -3.0701134573253940f, mx = -15.350567286626970f; return fabsf(mn + (mx - mn) * ((float)c * (1.f / 1023.f))); }

DEVI void taps_phase(const Params& p, int layer, const float* H2l, bf16_t* TAPS, float* INVN, unsigned char* shm) {
    float* w3s = (float*)shm;
    float* red = (float*)(shm + 4096);
    const int tid = otid(), lane = tid & 63, wid = tid >> 6, lr = lane & 15, lq = lane >> 4;
    const float* w3 = p.in[26] + (size_t)layer * 64 * 4096;
    for (int job = blockIdx.x; job < 256; job += gridDim.x) {
        const int o = job >> 7, c0 = (job & 127) * 8;
        for (int i = tid; i < 1024; i += 512) { const int j = i >> 4, q = i & 15; w3s[i] = w3[j * 4096 + (q >> 3) * 2048 + o * 1024 + c0 + (q & 7)]; }
        __syncthreads();
        bf16x8 bw[2];
#pragma unroll
        for (int ks = 0; ks < 2; ++ks) { float t[8];
#pragma unroll
            for (int i = 0; i < 8; ++i) t[i] = w3s[(ks * 32 + lq * 8 + i) * 16 + lr];
            bw[ks] = __builtin_bit_cast(bf16x8, pack8(t)); }
        const float delta = hy_delta(c0 + (lr & 7));
        bf16_t* dst = TAPS + ((size_t)((o * 2 + (lr >> 3)) * 1024 + c0 + (lr & 7))) * 4096;
        float part = 0.f;
#pragma unroll 2
        for (int tile = 0; tile < 32; ++tile) {
            const int tb = wid * 512 + tile * 16;
            const float* hr = H2l + (size_t)(tb + lr) * 64 + lq * 8;
            f32x4 acc = (f32x4){0.f, 0.f, 0.f, 0.f};
#pragma unroll
            for (int ks = 0; ks < 2; ++ks) { const f32x4 h0 = *(const f32x4*)(hr + ks * 32), h1 = *(const f32x4*)(hr + ks * 32 + 4);
                const float t[8] = {h0[0], h0[1], h0[2], h0[3], h1[0], h1[1], h1[2], h1[3]};
                acc = __builtin_amdgcn_mfma_f32_16x16x32_bf16(__builtin_bit_cast(bf16x8, pack8(t)), bw[ks], acc, 0, 0, 0); }
            const int t0 = tb + lq * 4;
            float v[4];
#pragma unroll
            for (int g = 0; g < 4; ++g) { v[g] = acc[g] * __expf(-((float)(t0 + g) * (1.f / 4095.f)) * delta); part += (lr >= 8 && t0 + g == 0) ? 0.f : fabsf(v[g]); }
            u32x2 w; w.x = cvt_pk_bf16(v[0], v[1]); w.y = cvt_pk_bf16(v[2], v[3]);
            *(u32x2*)(dst + t0) = w;
        }
        part += shx(part, lane, 16); part += shx(part, lane, 32);
        if (lq == 0) red[wid * 16 + lr] = part;
        __syncthreads();
        if (tid < 8) { float t = 0.f; for (int w = 0; w < 8; ++w) t += red[w * 16 + tid] + red[w * 16 + 8 + tid]; INVN[o * 1024 + c0 + tid] = 1.f / (t + 1e-6f); }
        __syncthreads();
    }
}

DEVI void taps_own(const Params& p, int layer, const float* H2l, bf16_t* TAPS, float* INVN, unsigned char* shm) {
    float* w3s = (float*)shm;
    float* red = (float*)(shm + 4096);
    const int tid = otid(), lane = tid & 63, wid = tid >> 6, lr = lane & 15, lq = lane >> 4;
    const float* w3 = p.in[26] + (size_t)layer * 64 * 4096;
    const int G = (int)gridDim.x;
    for (int cb = (int)blockIdx.x; cb < 1024; cb += 4 * G) {
        for (int i = tid; i < 1024; i += 512) { const int j = i >> 4, q = i & 15; int c = cb + (q & 3) * G; c = c < 1024 ? c : cb;
            w3s[i] = w3[j * 4096 + (q >> 3) * 2048 + ((q >> 2) & 1) * 1024 + c]; }
        __syncthreads();
        bf16x8 bw[2];
#pragma unroll
        for (int ks = 0; ks < 2; ++ks) { float t[8];
#pragma unroll
            for (int i = 0; i < 8; ++i) t[i] = w3s[(ks * 32 + lq * 8 + i) * 16 + lr];
            bw[ks] = __builtin_bit_cast(bf16x8, pack8(t)); }
        const int cmine = cb + (lr & 3) * G; const bool cok = cmine < 1024; const int cc = cok ? cmine : cb;
        const int om = (lr >> 2) & 1, dm = lr >> 3;
        const float delta = hy_delta(cc);
        bf16_t* dst = TAPS + ((size_t)((om * 2 + dm) * 1024 + cc)) * 4096;
        float part = 0.f;
#pragma unroll 2
        for (int tile = 0; tile < 32; ++tile) {
            const int tb = wid * 512 + tile * 16;
            const float* hr = H2l + (size_t)(tb + lr) * 64 + lq * 8;
            f32x4 acc = (f32x4){0.f, 0.f, 0.f, 0.f};
#pragma unroll
            for (int ks = 0; ks < 2; ++ks) { const f32x4 h0 = *(const f32x4*)(hr + ks * 32), h1 = *(const f32x4*)(hr + ks * 32 + 4);
                const float t[8] = {h0[0], h0[1], h0[2], h0[3], h1[0], h1[1], h1[2], h1[3]};
                acc = __builtin_amdgcn_mfma_f32_16x16x32_bf16(__builtin_bit_cast(bf16x8, pack8(t)), bw[ks], acc, 0, 0, 0); }
            const int t0 = tb + lq * 4;
            float v[4];
#pragma unroll
            for (int g = 0; g < 4; ++g) { v[g] = acc[g] * __expf(-((float)(t0 + g) * (1.f / 4095.f)) * delta); part += (dm == 1 && t0 + g == 0) ? 0.f : fabsf(v[g]); }
            u32x2 w; w.x = cvt_pk_bf16(v[0], v[1]); w.y = cvt_pk_bf16(v[2], v[3]);
            if (cok) *(u32x2*)(dst + t0) = w;
        }
        part += shx(part, lane, 16); part += shx(part, lane, 32);
        if (lq == 0) red[wid * 16 + lr] = part;
        __syncthreads();
        if (tid < 8) { float t = 0.f; for (int w = 0; w < 8; ++w) t += red[w * 16 + tid] + red[w * 16 + 8 + tid];
            const int c = cb + (tid & 3) * G; if (c < 1024) INVN[(tid >> 2) * 1024 + c] = 1.f / (t + 1e-6f); }
        __syncthreads();
    }
}

DEVI int padi(int i) { return i + ((i >> 5) << 1); }
DEVI f32x2 cmul(f32x2 a, f32x2 b) { return (f32x2){a.x * b.x - a.y * b.y, a.x * b.y + a.y * b.x}; }
DEVI f32x2 cmulc(f32x2 a, f32x2 b) { return (f32x2){a.x * b.x + a.y * b.y, a.y * b.x - a.x * b.y}; }
DEVI f32x2 twid(int m, float invN) {
    const float fr = (float)m * invN, qf = rintf(fr * 4.f), r = fr - qf * 0.25f, ph = r * 6.283185307179586f, p2 = ph * ph;
    const float s = ph * (1.f + p2 * (-1.f / 6.f + p2 * (1.f / 120.f + p2 * (-1.f / 5040.f + p2 * (1.f / 362880.f)))));
    const float c = 1.f + p2 * (-0.5f + p2 * (1.f / 24.f + p2 * (-1.f / 720.f + p2 * (1.f / 40320.f + p2 * (-1.f / 3628800.f)))));
    const int q = ((int)qf) & 3;
    const float cs = (q == 0) ? c : (q == 1) ? -s : (q == 2) ? -c : s;
    const float sn = (q == 0) ? s : (q == 1) ? c : (q == 2) ? -s : -c;
    return (f32x2){cs, -sn};
}
#define W16C(m) ((m) == 0 ? 1.f : (m) == 1 ? 0.9238795325112867f : (m) == 2 ? 0.7071067811865476f : (m) == 3 ? 0.3826834323650898f : (m) == 4 ? 0.f : (m) == 5 ? -0.3826834323650898f : (m) == 6 ? -0.7071067811865476f : -0.9238795325112867f)
#define W16S(m) ((m) == 0 ? 0.f : (m) == 1 ? -0.3826834323650898f : (m) == 2 ? -0.7071067811865476f : (m) == 3 ? -0.9238795325112867f : (m) == 4 ? -1.f : (m) == 5 ? -0.9238795325112867f : (m) == 6 ? -0.7071067811865476f : -0.3826834323650898f)

DEVI f32x2 rot16(f32x2 t, int m) { return m == 0 ? t : (m == 4 ? (f32x2){t.y, -t.x} : cmul(t, (f32x2){W16C(m), W16S(m)})); }
template <bool INV> DEVI void bfly16(f32x2 (&x)[16], f32x2 t1) {
    f32x2 tq[4]; tq[0] = t1; tq[1] = cmul(tq[0], tq[0]); tq[2] = cmul(tq[1], tq[1]); tq[3] = cmul(tq[2], tq[2]);
    if (!INV) {
#pragma unroll
        for (int q = 0; q < 4; ++q) { const int half = 8 >> q;
#pragma unroll
            for (int blk = 0; blk < (1 << q); ++blk)
#pragma unroll
                for (int jj = 0; jj < half; ++jj) { const int i0 = blk * 2 * half + jj, i1 = i0 + half; const int m = (jj << q) & 15;
                    const f32x2 T = rot16(tq[q], m);
                    const f32x2 a = x[i0], b = x[i1]; x[i0] = a + b; x[i1] = cmul(a - b, T); } }
    } else {
#pragma unroll
        for (int q = 3; q >= 0; --q) { const int half = 8 >> q;
#pragma unroll
            for (int blk = 0; blk < (1 << q); ++blk)
#pragma unroll
                for (int jj = 0; jj < half; ++jj) { const int i0 = blk * 2 * half + jj, i1 = i0 + half; const int m = (jj << q) & 15;
                    const f32x2 T = rot16(tq[q], m);
                    const f32x2 a = x[i0], b = cmulc(x[i1], T); x[i0] = a + b; x[i1] = a - b; } }
    }
}
template <int S0, bool INV, bool EDGE = false> DEVI void fft_pass(f32x2* buf, int tid_, f32x2 t1_) {
    int tid = tid_; asm volatile("" : "+v"(tid));
    float t1x = t1_.x, t1y = t1_.y; asm volatile("" : "+v"(t1x), "+v"(t1y));
    const f32x2 t1 = (f32x2){t1x, t1y};
    constexpr int stride = 8192 >> (S0 + 4);
    constexpr int cs = S0 == 0 ? 544 : (S0 == 4 ? 34 : 2);
    const int lo = tid & (stride - 1), hi = tid / stride;
    const int pbase = S0 == 0 ? padi(tid) : (S0 == 4 ? hi * 544 + lo : hi * 34 + lo);
    f32x2* pb = buf + pbase;
    f32x2 x[16];
#pragma unroll
    for (int j = 0; j < 16; ++j) x[j] = (EDGE && !INV && j >= 8) ? (f32x2){0.f, 0.f} : pb[j * cs];
    bfly16<INV>(x, t1);
#pragma unroll
    for (int j = 0; j < 16; ++j) if (!(EDGE && INV && j >= 8)) pb[j * cs] = x[j];
}
DEVI float dpp_swap1(float v) { return __int_as_float(__builtin_amdgcn_mov_dpp(__float_as_int(v), 0xB1, 0xF, 0xF, true)); }
template <int MODE> DEVI void fft_mid3(f32x2* buf, const f32x2* hbuf, int tid_, f32x2 t1_) {
    int tid = tid_; asm volatile("" : "+v"(tid));
    float t1x = t1_.x, t1y = t1_.y; asm volatile("" : "+v"(t1x), "+v"(t1y));
    const f32x2 t1 = (f32x2){t1x, t1y};
    const int lo = tid & 1, hi = tid >> 1;
    f32x2* pb = buf + hi * 34 + lo;
    f32x2 x[16];
#pragma unroll
    for (int j = 0; j < 16; ++j) x[j] = pb[j * 2];
    bfly16<false>(x, t1);
#pragma unroll
    for (int j = 0; j < 16; ++j) { const f32x2 rc = (f32x2){dpp_swap1(x[j].x), dpp_swap1(x[j].y)}; x[j] = lo ? rc - x[j] : x[j] + rc; }
    if (MODE != 0) {
        const f32x2* hb = hbuf + hi * 34 + lo;
#pragma unroll
        for (int j = 0; j < 16; ++j) { const int m = hi * 16 + j;
            const f32x2 f = hb[j * 2];
            const int k0 = (int)(__brev((unsigned)m) >> 20), mp = (int)(__brev((unsigned)((4096 - k0) & 4095)) >> 20);
            const int pp = m == 0 ? lo : 2 * mp + (1 - lo);
            const f32x2 gq = hbuf[padi(pp)]; const f32x2 g = (f32x2){gq.x, -gq.y};
            f32x2 h; if (MODE == 1) h = f + g; else { const f32x2 d = f - g; h = (f32x2){d.y, -d.x}; }
            x[j] = cmul(x[j], h); }
#pragma unroll
        for (int j = 0; j < 16; ++j) { const f32x2 rc = (f32x2){dpp_swap1(x[j].x), dpp_swap1(x[j].y)}; x[j] = lo ? rc - x[j] : x[j] + rc; }
        bfly16<true>(x, t1);
    }
#pragma unroll
    for (int j = 0; j < 16; ++j) pb[j * 2] = x[j];
}
template <int MODE> DEVI void fft_mid(f32x2* buf, const f32x2* hbuf, int tid_) {
    int tid = tid_; asm volatile("" : "+v"(tid));
#pragma unroll
    for (int k = 0; k < 8; ++k) { const int m = tid + 512 * k, idx = padi(2 * m);
        const f32x4 v = *(const f32x4*)(buf + idx); f32x2 a = (f32x2){v[0], v[1]}, b = (f32x2){v[2], v[3]}; f32x2 x0 = a + b, x1 = a - b;
        if (MODE != 0) {
            const f32x4 hv = *(const f32x4*)(hbuf + idx);
            const int k0 = (int)(__brev((unsigned)m) >> 20), mp = (int)(__brev((unsigned)((4096 - k0) & 4095)) >> 20);
            const f32x4 pv = *(const f32x4*)(hbuf + padi(2 * mp));
            const f32x2 f0 = (f32x2){hv[0], hv[1]}, f1 = (f32x2){hv[2], hv[3]};
            const f32x2 g0 = m == 0 ? (f32x2){hv[0], -hv[1]} : (f32x2){pv[2], -pv[3]};
            const f32x2 g1 = m == 0 ? (f32x2){hv[2], -hv[3]} : (f32x2){pv[0], -pv[1]};
            f32x2 h0, h1;
            if (MODE == 1) { h0 = f0 + g0; h1 = f1 + g1; }
            else { const f32x2 d0 = f0 - g0, d1 = f1 - g1; h0 = (f32x2){d0.y, -d0.x}; h1 = (f32x2){d1.y, -d1.x}; }
            const f32x2 y0 = cmul(x0, h0), y1 = cmul(x1, h1); x0 = y0 + y1; x1 = y0 - y1; }
        *(f32x4*)(buf + idx) = (f32x4){x0.x, x0.y, x1.x, x1.y}; }
}
DEVI void sconv8(const bf16_t* row, int t0, int rowmask, float w0, float w1, float w2, float bias, float* out) {
    float u[10]; unpack8(*(const u32x4*)(row + t0), u + 1);
    { const bool el = (t0 & rowmask) == 0, er = ((t0 + 8) & rowmask) == 0; const bf16_t vl = row[t0 - 1 + (el ? 1 : 0)], vr = row[t0 + 8 - (er ? 1 : 0)];
      u[0] = el ? 0.f : bf2f(vl); u[9] = er ? 0.f : bf2f(vr); }
#pragma unroll
    for (int e = 0; e < 8; ++e) out[e] = w0 * u[e] + w1 * u[e + 1] + w2 * u[e + 2] + bias;
}

struct Raw8 { u32x4 m; unsigned l, r; };
DEVI Raw8 raw8_load(const bf16_t* row, int t0, bool nb) { Raw8 x; x.m = *(const u32x4*)(row + t0); x.l = 0u; x.r = 0u;
    if (nb) { const bool el = (t0 & 63) == 0, er = ((t0 + 8) & 63) == 0;
        const unsigned vl = row[t0 - 1 + (el ? 1 : 0)], vr = row[t0 + 8 - (er ? 1 : 0)]; x.l = el ? 0u : vl; x.r = er ? 0u : vr; } return x; }
DEVI void sconv8_fin(const Raw8& x, float w0, float w1, float w2, float bias, float* out) {
    float u[10]; unpack8(x.m, u + 1); u[0] = __uint_as_float(x.l << 16); u[9] = __uint_as_float(x.r << 16);
#pragma unroll
    for (int e = 0; e < 8; ++e) out[e] = w0 * u[e] + w1 * u[e + 1] + w2 * u[e + 2] + bias;
}

DEVI void hyena_phase(const Params& p, int layer, bf16_t* Hch, bf16_t* TAPS, float* INVN, const float* H2l, const float* H2c, bool do_ctx, unsigned char* smem) {
    taps_own(p, layer, H2l, TAPS, INVN, smem);
    f32x2* bufA = (f32x2*)smem;
    f32x2* bufH = (f32x2*)(smem + 69632);
    float* sred = (float*)(smem + 139264);
    const int tid = otid(), lane = tid & 63, wid = tid >> 6, t0 = tid * 8;
    const float* cw = p.in[18] + layer * 3 * 3072; const float* cb = p.in[19] + layer * 3072;
    f32x2* twt = (f32x2*)(smem + 139264 + 256);
    twt[tid] = twid(tid, 1.f / 8192.f); if (tid < 32) twt[512 + tid] = twid(tid << 4, 1.f / 8192.f);
    __syncthreads();
#define tw0 (twt[tid])
#define tw4 (twt[512 + (tid & 31)])
#define tw8 ((tid & 1) ? (f32x2){0.9807852804032304f, -0.19509032201612825f} : (f32x2){1.f, 0.f})
    u32x4 tw_[4]; float invn0, invn1;
#define HY_TAPS(cn_) do { _Pragma("unroll") for (int q_ = 0; q_ < 4; ++q_) tw_[q_] = *(const u32x4*)(TAPS + ((size_t)(q_ * 1024 + (cn_))) * 4096 + t0); invn0 = INVN[(cn_)]; invn1 = INVN[1024 + (cn_)]; } while (0)
    for (int c = blockIdx.x; c < 1024; c += gridDim.x) {
        bf16_t* vrow = Hch + (size_t)c * MTOT;
        const float vw0 = cw[c], vw1 = cw[3072 + c], vw2 = cw[6144 + c], vb = cb[c];
        HY_TAPS(c);
        { float f0[8], b0[8], f1[8], b1[8]; unpack8(tw_[0], f0); unpack8(tw_[1], b0); unpack8(tw_[2], f1); unpack8(tw_[3], b1);
#pragma unroll
          for (int e = 0; e < 8; ++e) { bufH[padi(t0 + e)] = (f32x2){f0[e] * invn0, f1[e] * invn1}; const int m = t0 + e;
              if (m >= 1) bufH[padi(8192 - m)] = (f32x2){b0[e] * invn0, b1[e] * invn1}; else bufH[padi(4096)] = (f32x2){0.f, 0.f}; } }
        Raw8 za = raw8_load(vrow, t0, true), zb = raw8_load(vrow + 4096, t0, true);
        __syncthreads();
        fft_pass<0, false>(bufH, tid, tw0); __syncthreads(); fft_pass<4, false>(bufH, tid, tw4); __syncthreads(); fft_mid3<0>(bufH, bufH, tid, tw8); __syncthreads();
        for (int o = 0; o < 2; ++o) {
            const int gch = (o + 1) * 1024 + c; const bf16_t* grow = Hch + (size_t)gch * MTOT;
            const float gw0 = cw[gch], gw1 = cw[3072 + gch], gw2 = cw[6144 + gch], gb = cb[gch];
            const float bias = p.in[27][(layer * 2 + o) * 1024 + c];
            for (int pr = 0; pr < 2; ++pr) {
                float z0[8], z1[8];
                if (o == 0) { sconv8_fin(za, vw0, vw1, vw2, vb, z0); sconv8_fin(zb, vw0, vw1, vw2, vb, z1); }
                else { unpack8(za.m, z0); unpack8(zb.m, z1); }
#pragma unroll
                for (int e = 0; e < 8; ++e) bufA[padi(t0 + e)] = (f32x2){z0[e], z1[e]};
                __syncthreads();
                fft_pass<0, false, true>(bufA, tid, tw0); __syncthreads(); fft_pass<4, false>(bufA, tid, tw4); __syncthreads();
                if (o == 0) fft_mid3<1>(bufA, bufH, tid, tw8); else fft_mid3<2>(bufA, bufH, tid, tw8);
                __syncthreads();
                const Raw8 ga = raw8_load(grow + (2 * pr) * 4096, t0, true), gc = raw8_load(grow + (2 * pr + 1) * 4096, t0, true);
                if (pr == 0) { za = raw8_load(vrow + 2 * 4096, t0, o == 0); zb = raw8_load(vrow + 3 * 4096, t0, o == 0); }
                fft_pass<4, true>(bufA, tid, tw4); __syncthreads(); fft_pass<0, true, true>(bufA, tid, tw0); __syncthreads();
                float g0[8], g1[8], r0[8], r1[8];
                sconv8_fin(ga, gw0, gw1, gw2, gb, g0); sconv8_fin(gc, gw0, gw1, gw2, gb, g1);
#pragma unroll
                for (int e = 0; e < 8; ++e) { const f32x2 y = bufA[padi(t0 + e)]; r0[e] = g0[e] * (y.x * (1.f / 16384.f) + bias * z0[e]); r1[e] = g1[e] * (y.y * (1.f / 16384.f) + bias * z1[e]); }
                *(u32x4*)(vrow + (2 * pr) * 4096 + t0) = pack8(r0); *(u32x4*)(vrow + (2 * pr + 1) * 4096 + t0) = pack8(r1);
                if (o == 0 && pr == 1) { __syncthreads(); za = raw8_load(vrow, t0, false); zb = raw8_load(vrow + 4096, t0, false); }
                __syncthreads();
            }
        }
        if (do_ctx) {
            float* hh = (float*)smem;
            float* zc = hh + 1024;
            float* g1c = zc + 1024; float* g2c = g1c + 1024; float* z2c = g2c + 1024;
            float* w3c = z2c + 1024;
            const float* w3 = p.in[26] + (size_t)layer * 64 * 4096;
            if (tid < 256) { const int j = tid >> 2, q = tid & 3; w3c[tid] = w3[j * 4096 + (q >> 1) * 2048 + (q & 1) * 1024 + c]; }
            if (tid < 384) { const int which = tid >> 7, rem = tid & 127, b = rem >> 5, tt = (rem & 31) * 8; const int ch = which * 1024 + c;
                float ov[8]; sconv8(Hch + (size_t)ch * MTOT + MLAT + b * 256, tt, 255, cw[ch], cw[3072 + ch], cw[6144 + ch], cb[ch], ov);
                float* dst = (which == 0 ? zc : which == 1 ? g1c : g2c) + b * 256 + tt;
#pragma unroll
                for (int e = 0; e < 8; ++e) dst[e] = ov[e]; }
            __syncthreads();
            { const int t = tid & 255, dir = tid >> 8; float a0 = 0.f, a1 = 0.f; const float* hr = H2c + t * 64;
#pragma unroll
              for (int j4 = 0; j4 < 16; ++j4) { const f32x4 hv = *(const f32x4*)(hr + j4 * 4);
#pragma unroll
                  for (int jj = 0; jj < 4; ++jj) { const float* wq = w3c + (j4 * 4 + jj) * 4 + dir * 2; a0 += hv[jj] * wq[0]; a1 += hv[jj] * wq[1]; } }
              const float win = __expf(-((float)t * (1.f / 255.f)) * hy_delta(c)); a0 *= win; a1 *= win;
              if (dir == 0) { hh[255 + t] = a0; hh[512 + 255 + t] = a1; } else if (t >= 1) { hh[255 - t] = a0; hh[512 + 255 - t] = a1; }
              if (tid == 0) { hh[511] = 0.f; hh[1023] = 0.f; }
              float s0 = (dir == 1 && t == 0) ? 0.f : fabsf(a0), s1 = (dir == 1 && t == 0) ? 0.f : fabsf(a1);
              s0 = wave_sum(s0, lane); s1 = wave_sum(s1, lane); if (lane == 0) { sred[wid * 2] = s0; sred[wid * 2 + 1] = s1; } }
            __syncthreads();
            float inv0, inv1; { float s0 = 0.f, s1 = 0.f; for (int w = 0; w < 8; ++w) { s0 += sred[w * 2]; s1 += sred[w * 2 + 1]; } inv0 = 1.f / (s0 + 1e-6f); inv1 = 1.f / (s1 + 1e-6f); }
            const float bias0 = p.in[27][(layer * 2 + 0) * 1024 + c], bias1 = p.in[27][(layer * 2 + 1) * 1024 + c];
            const int t = tid & 255, bb = tid >> 8;
#pragma unroll 1
            for (int o = 0; o < 2; ++o) {
                const float* hq = hh + o * 512 + t + 255; const float* zin = (o == 0 ? zc : z2c) + bb * 256; const float* gin = (o == 0 ? g1c : g2c) + bb * 256;
                float y0 = 0.f, y1 = 0.f;
#pragma unroll 8
                for (int s2 = 0; s2 < 256; ++s2) { const float h = hq[-s2]; y0 += h * zin[s2]; y1 += h * zin[512 + s2]; }
                const float inv = o == 0 ? inv0 : inv1, bias = o == 0 ? bias0 : bias1;
                const float r0 = gin[t] * (y0 * inv + bias * zin[t]), r1 = gin[512 + t] * (y1 * inv + bias * zin[512 + t]);
                if (o == 0) { __syncthreads(); z2c[bb * 256 + t] = r0; z2c[(bb + 2) * 256 + t] = r1; }
                else { Hch[(size_t)c * MTOT + MLAT + bb * 256 + t] = f2bf(r0); Hch[(size_t)c * MTOT + MLAT + (bb + 2) * 256 + t] = f2bf(r1); }
                __syncthreads();
            }
        }
    }
}

#undef tw0
#undef tw4
#undef tw8
#define XB_TMO      128
#define XB_XCNT(j)  (256  + 64 * (j))
#define XB_XSUB(j)  (1280 + 64 * (j))
#define XB_XGEN(j)  (2304 + 64 * (j))
#define XB_TOP      3328
#define XB_TOPGEN   3392
#define XCD_BAR_WORDS 3456
#define XB_SPIN_CAP (1u << 20)
DEVI unsigned xb_ld(unsigned* p)              { return __hip_atomic_load(p, __ATOMIC_RELAXED, __HIP_MEMORY_SCOPE_AGENT); }
DEVI unsigned xb_add(unsigned* p, unsigned v) { return __hip_atomic_fetch_add(p, v, __ATOMIC_RELAXED, __HIP_MEMORY_SCOPE_AGENT); }
DEVI unsigned xb_xcc_id() { return (unsigned)__builtin_amdgcn_s_getreg((3 << 11) | 20) & 0xFu; }
#define XB_SPIN(cond, bar) do { unsigned _sp = 0; while (cond) { __builtin_amdgcn_s_sleep(1); \
    if ((++_sp & 255u) == 0u) { if (xb_ld(&(bar)[XB_TMO])) break; if (_sp > XB_SPIN_CAP) { atomicAdd(&(bar)[XB_TMO], 1u); break; } } } } while (0)
struct XcdBarrier { unsigned* bar; unsigned x; volatile LAS unsigned* st; };
DEVI XcdBarrier xcd_barrier_post(unsigned* bar, volatile LAS unsigned* st) {
    XcdBarrier b; b.bar = bar; b.x = xb_xcc_id(); b.st = st;
    if (threadIdx.x == 0) (void)xb_add(&bar[XB_XCNT(b.x)], 1u);
    return b;
}
DEVI void xcd_barrier_complete(unsigned* bar, unsigned x, unsigned& nloc, unsigned& nx) {
    const unsigned G = gridDim.x * gridDim.y * gridDim.z;
    unsigned sum, cnt, mine, sp = 0u;
    for (;;) {
        sum = 0u; cnt = 0u; mine = 0u;
#pragma unroll
        for (unsigned j = 0; j < 16; ++j) { const unsigned c = xb_ld(&bar[XB_XCNT(j)]); sum += c; cnt += (c > 0u) ? 1u : 0u; mine = (j == x) ? c : mine; }
        if (sum == G) break;
        __builtin_amdgcn_s_sleep(1);
        if ((++sp & 255u) == 0u) { if (xb_ld(&bar[XB_TMO])) break; if (sp > XB_SPIN_CAP) { atomicAdd(&bar[XB_TMO], 1u); break; } }
    }
    nloc = mine > 0u ? mine : 1u; nx = cnt > 0u ? cnt : 1u;
}
DEVI void xcd_barrier(const XcdBarrier& b) {
    asm volatile("s_waitcnt vmcnt(0)" ::: "memory");
    __syncthreads();
    if (threadIdx.x == 0) {
        unsigned* bar = b.bar;
        __builtin_amdgcn_s_waitcnt(0);
        unsigned nloc = b.st[0], nx = b.st[1];
        if (nloc == 0u) { xcd_barrier_complete(bar, b.x, nloc, nx); b.st[0] = nloc; b.st[1] = nx; }
        const unsigned old = xb_add(&bar[XB_XSUB(b.x)], 1u);
        const unsigned gen = old / nloc;
        if (old + 1u == (gen + 1u) * nloc) {
            __builtin_amdgcn_fence(__ATOMIC_RELEASE, "agent");
            asm volatile("s_waitcnt vmcnt(0)" ::: "memory");
            const unsigned og = xb_add(&bar[XB_TOP], 1u);
            const unsigned tg = og / nx;
            if (og + 1u == (tg + 1u) * nx) xb_add(&bar[XB_TOPGEN], 1u);
            else XB_SPIN(xb_ld(&bar[XB_TOPGEN]) == tg, bar);
            __builtin_amdgcn_fence(__ATOMIC_ACQUIRE, "agent");
            xb_add(&bar[XB_XGEN(b.x)], 1u);
            asm volatile("s_waitcnt vmcnt(0)" ::: "memory");
        } else {
            XB_SPIN(xb_ld(&bar[XB_XGEN(b.x)]) == gen, bar);
            __builtin_amdgcn_fence(__ATOMIC_ACQUIRE, "agent");
            asm volatile("s_waitcnt vmcnt(0)" ::: "memory");
        }
    }
    __syncthreads();
}

__global__ void __launch_bounds__(512) hybrid_forward(Params p) {
    extern __shared__ __attribute__((aligned(16))) unsigned char shm[];
    cg::grid_group grid = cg::this_grid();
    unsigned char* ws = p.ws;
    float* X = (float*)(ws + WS_X);
    unsigned char* R = ws + WS_R; unsigned char* W = ws + WS_W;
    float* MOD = (float*)(ws + WS_MOD); float* H2 = (float*)(ws + WS_H2); float* INVN = (float*)(ws + WS_INVN);
    bf16_t* Hn = (bf16_t*)p.out;
    bf16_t* ACT = (bf16_t*)(R + R_ACT); bf16_t* Pg = (bf16_t*)(R + R_PG); bf16_t* Ob = (bf16_t*)(R + R_OB); bf16_t* Hch = (bf16_t*)(R + R_HCH);
    bf16_t* G = (bf16_t*)(R + R_G); bf16_t* Of = (bf16_t*)(R + R_OF); float* T1 = (float*)(R + R_T1); bf16_t* Am = (bf16_t*)(R + R_AM);
    bf16_t* TAPS = (bf16_t*)(W + W_GU1);
    bf16_t* QF = (bf16_t*)(R + 4 * U + U / 4);
    float* DEC = (float*)(R + 4 * U + U / 4 + U / 2);
    bf16_t* KF = (bf16_t*)((unsigned char*)p.out + U);
    bf16_t* ATTf = (bf16_t*)(W + W_GU1);
    bf16_t* ATTb = (bf16_t*)((unsigned char*)p.out + U + U / 2);
    float* PART = (float*)(R + 3 * U);

    { volatile LAS unsigned* st = (volatile LAS unsigned*)(LAS unsigned char*)(shm + LDS_BYTES - 16); if (otid() == 0) { st[0] = 0u; st[1] = 0u; st[2] = 0u; st[3] = 0u; } }
    __syncthreads();
    const XcdBarrier xb = xcd_barrier_post((unsigned*)(ws + WS_BAR), (volatile LAS unsigned*)(LAS unsigned char*)(shm + LDS_BYTES - 16));
    if (otid() == 0) { volatile LAS unsigned* st = (volatile LAS unsigned*)(LAS unsigned char*)(shm + LDS_BYTES - 16); st[2] = xb_add((unsigned*)(ws + WS_BAR) + 3520 + 64 * xb.x, 1u); }
    xinit_phase(p, X); mod_phase(p, MOD, shm); h2_phase(p, H2, shm); convert_phase(p, 0, W, shm);
    xcd_barrier(xb);
    if (p.ws == nullptr) grid.sync();
    int vc = -1;
    { unsigned* bar = (unsigned*)(ws + WS_BAR); bool even = gridDim.x == 256u;
      for (int j = 0; j < 8; ++j) even = even && (xb_ld(&bar[XB_XCNT(j)]) == 32u);
      const unsigned rank = ((volatile LAS unsigned*)(LAS unsigned char*)(shm + LDS_BYTES - 16))[2];
      if (even && rank < 32u && xb.x < 8u) vc = (int)(rank * 8u + xb.x);
      vc = __builtin_amdgcn_readfirstlane(vc); }
#pragma unroll 1
    for (int layer = 0; layer < 2; ++layer) {
        const bool last = layer == 1; const int Mmix = last ? MLAT : MTOT;
        const float* modl = MOD + layer * 5 * 9216;
        if (layer > 0) convert_phase(p, layer, W, shm);
        if (LIMIT & 1) norm_phase(X, Hn, p.in[6] + layer * 1024, modl, 0, 1, MTOT, PART, layer > 0 ? 11 : 0, layer == 0 ? p.in[0] : nullptr);
        xcd_barrier(xb);
        if (LIMIT & 1) { EpiSwiglu E; E.O = ACT; run_gemm(shm, Hn, (const bf16_t*)(W + W_GU1), MTOT, 2 * DFF, 1024, E); }
        xcd_barrier(xb);
        if (LIMIT & 1) { EpiResid E; E.X = X; E.mod = modl; E.Xin = layer == 0 ? p.in[0] : X; E.idx = 2; E.scale = 0.5f; E.part = PART; run_gemm_split(shm, ACT, (const bf16_t*)(W + W_D1), MLAT, MTOT, 1024, DFF, E); }
        xcd_barrier(xb);
        if (LIMIT & 2) norm_phase(X, Hn, p.in[10] + layer * 1024, modl, 3, 4, MTOT, PART, 11);
        xcd_barrier(xb);
        if (LIMIT & 2) { EpiBf16<0> E; E.O = Pg; E.ldc = PGW; run_gemm(shm, Hn, (const bf16_t*)(W + W_IN), MTOT, PGW, 1024, E); }
        xcd_barrier(xb);
        if (LIMIT & 4) gla_prep_phase(p, layer, vc, Pg, QF, KF, DEC, ATTf, ATTb, shm);
        xcd_barrier(xb);
        if (LIMIT & 4) gla_phase(p, layer, vc, Pg, QF, KF, DEC, ATTf, ATTb, Of, Ob, shm);
        xcd_barrier(xb);
        if (LIMIT & 4) gla_post_phase(p, layer, Pg, Of, Ob, Mmix);
        xcd_barrier(xb);
        if (LIMIT & 8) { EpiBf16<0> E; E.O = Hch; E.ldc = MTOT; run_gemm(shm, (const bf16_t*)(W + W_IN) + (size_t)PGW * 1024, Hn, 3072, Mmix, 1024, E); }
        if (LIMIT & 8) { EpiBf16<1> E; E.O = G; E.ldc = 2048; run_gemm(shm, Hn, (const bf16_t*)(W + W_IN) + (size_t)6400 * 1024, Mmix, 2048, 1024, E, true); }
        xcd_barrier(xb);
        if (LIMIT & 16) hyena_phase(p, layer, Hch, TAPS, INVN, H2 + (size_t)layer * 4352 * 64, H2 + ((size_t)layer * 4352 + 4096) * 64, !last, shm);
        xcd_barrier(xb);
        if (LIMIT & 16) transpose_phase(Hch, Hn, Mmix, shm);
        xcd_barrier(xb);
        if (LIMIT & 32) { EpiGateA E; E.T1 = T1; E.G = G; run_gemm(shm, Of, (const bf16_t*)(W + W_GO), Mmix, 1024, 1024, E); }
        if (LIMIT & 32) { EpiGateB E; E.T1 = T1; E.G = G; E.Am = Am; run_gemm(shm, Hn, (const bf16_t*)(W + W_HO), Mmix, 1024, 1024, E); }
        xcd_barrier(xb);
        if (LIMIT & 32) { EpiResid E; E.X = X; E.mod = modl; E.Xin = X; E.idx = 5; E.scale = 1.0f; E.part = PART; run_gemm_split(shm, Am, (const bf16_t*)(W + W_O), MLAT, Mmix, 1024, 1024, E); }
        xcd_barrier(xb);
        if (LIMIT & 64) norm_phase(X, Hn, p.in[30] + layer * 1024, modl, 6, 7, Mmix, PART, 4);
        xcd_barrier(xb);
        if (LIMIT & 64) { EpiSwiglu E; E.O = ACT; run_gemm(shm, Hn, (const bf16_t*)(W + W_GU2), Mmix, 2 * DFF, 1024, E); }
        xcd_barrier(xb);
        if (LIMIT & 64) { EpiResid E; E.X = X; E.mod = modl; E.Xin = X; E.idx = 8; E.scale = 0.5f; E.part = PART; run_gemm_split(shm, ACT, (const bf16_t*)(W + W_D2), MLAT, Mmix, 1024, DFF, E); }
        xcd_barrier(xb);
    }
    final_norm_phase(X, p.out, p.in[34]);
}

extern "C" void kernel_launch(void* const* d_in, const int* in_sizes, int n_in, void* d_out, int out_size, void* d_ws, size_t ws_size, hipStream_t stream) {
    static int grid_blocks = 0;
    if (!grid_blocks) {
        int dev = 0, cus = 0, per_cu = 0;
        hipGetDevice(&dev);
        hipDeviceGetAttribute(&cus, hipDeviceAttributeMultiprocessorCount, dev);
        hipFuncSetAttribute((const void*)hybrid_forward, hipFuncAttributeMaxDynamicSharedMemorySize, LDS_BYTES);
        hipOccupancyMaxActiveBlocksPerMultiprocessor(&per_cu, (const void*)hybrid_forward, 512, LDS_BYTES);
        if (per_cu < 1) per_cu = 1;
        grid_blocks = cus * per_cu;
        if (ws_size < WS_END) fprintf(stderr, "kernel_launch: workspace too small: %zu < %zu\n", ws_size, (size_t)WS_END);
    }
    (void)hipMemsetAsync((unsigned char*)d_ws + WS_BAR, 0, 16384, stream);
    Params p{};
    for (int i = 0; i < 35; ++i) p.in[i] = (const float*)d_in[i];
    p.out = (float*)d_out; p.ws = (unsigned char*)d_ws;
    void* args[] = {&p};
    hipError_t e = hipLaunchCooperativeKernel((const void*)hybrid_forward, dim3(grid_blocks), dim3(512), args, LDS_BYTES, stream);
    if (e != hipSuccess) fprintf(stderr, "cooperative launch failed: %s (grid %d)\n", hipGetErrorString(e), grid_blocks);
}
```
